# Optimizing an MI355X kernel written in HIP

```python
import math
import jax, jax.numpy as jnp
from jax import lax
import numpy as np


D_MODEL = 1024
BATCH = 16
SEQ = 4096
DEPTH = 1

POOL_WIDTH = D_MODEL // 2
POOL_WINDOWS = (2, 4, 8, 16)
N_POOL_GROUPS = len(POOL_WINDOWS)
POOL_GROUP = POOL_WIDTH // N_POOL_GROUPS
HEAD_DIM = 64
N_HEADS = (D_MODEL // 2) // HEAD_DIM
N_KV = 2
HEADS_PER_KV = N_HEADS // N_KV
Q_WIDTH = N_HEADS * HEAD_DIM
KV_WIDTH = N_KV * HEAD_DIM
CMP_STRIDE = 16
CMP_BLOCK = 2 * CMP_STRIDE
CMP_HIDDEN = 4 * HEAD_DIM
SLC_BLOCK = 64
N_SELECT = 16
WINDOW = 512
Q_BLOCK = SLC_BLOCK
ALIBI_MAX = 8.0
MIX_SIZES = (POOL_WIDTH, Q_WIDTH, KV_WIDTH, KV_WIDTH, KV_WIDTH, KV_WIDTH, KV_WIDTH, KV_WIDTH, 3 * N_HEADS, 2 * D_MODEL)
MIX_IN = sum(MIX_SIZES)
V_SLOTS = (3, 5, 7)
D_FF = 2816
ALPHA = (2.0 * DEPTH) ** 0.25
BETA = (8.0 * DEPTH) ** -0.25
LN_EPS = 1e-5
NEG = -1e30
FORCE = 1e9

kernel_name = 'hybrid_pool_nsa_macaron_block'


def layer_norm(x, g, b):
    xf = x.astype(jnp.float32)
    mu = jnp.mean(xf, axis=-1, keepdims=True)
    var = jnp.mean(jnp.square(xf - mu), axis=-1, keepdims=True)
    return ((xf - mu) * lax.rsqrt(var + LN_EPS) * g + b).astype(x.dtype)


def swiglu(h, w_in, w_out):
    gate, up = jnp.split(h @ w_in, 2, axis=-1)
    return (jax.nn.silu(gate) * up) @ w_out


def masked_softmax(s, mask):
    p = jax.nn.softmax(jnp.where(mask, s, NEG), axis=-1)
    return jnp.where(mask, p, 0.0)


def alibi_slopes(n_heads):
    return (2.0 ** (-ALIBI_MAX * np.arange(1, n_heads + 1) / n_heads)).astype(np.float32)


def cmp_to_slc_overlap(n_cmp, n_slc):
    start = np.arange(n_cmp)[:, None] * CMP_STRIDE
    blk = np.arange(n_slc)[None, :] * SLC_BLOCK
    return ((start < blk + SLC_BLOCK) & (start + CMP_BLOCK > blk)).astype(np.float32)


def pool_mixer(u, pool_w, pool_scale):
    b_, s_, p_ = u.shape
    uf = u.astype(jnp.float32)
    cs = jnp.concatenate([jnp.zeros((b_, 1, p_), jnp.float32), jnp.cumsum(uf, axis=1)], axis=1)
    t = jnp.arange(s_)
    means = []
    for gi, w in enumerate(POOL_WINDOWS):
        csg = cs[:, :, gi * POOL_GROUP:(gi + 1) * POOL_GROUP]
        lo = jnp.maximum(t + 1 - w, 0)
        cnt = (t + 1 - lo).astype(jnp.float32)
        means.append((csg[:, 1:] - csg[:, lo]) / cnt[None, :, None])
    pooled = jnp.stack(means, axis=2)
    delta = (pooled - uf.reshape(b_, s_, N_POOL_GROUPS, POOL_GROUP)).astype(u.dtype)
    mixed = jnp.einsum('bsgc,gcd->bsgd', delta, pool_w)
    return mixed.reshape(b_, s_, p_) * pool_scale


def compress(k, pos, w1, w2):
    b_, g_, s_, d_ = k.shape
    kc = k.reshape(b_, g_, s_ // CMP_STRIDE, CMP_STRIDE, d_)
    blocks = jnp.concatenate([kc[:, :, :-1], kc[:, :, 1:]], axis=3) + pos
    blocks = blocks.reshape(b_, g_, -1, CMP_BLOCK * d_)
    return jax.nn.gelu(blocks @ w1) @ w2


def nsa_attention(q, k_cmp, v_cmp, k_slc, v_slc, k_win, v_win, g_nsa,
                  cmp_pos_k, cmp_k_w1, cmp_k_w2, cmp_pos_v, cmp_v_w1, cmp_v_w2):
    b_, s_, _ = q.shape
    dt = q.dtype
    f32 = jnp.float32
    q = (q * HEAD_DIM ** -0.5).reshape(b_, s_, N_KV, HEADS_PER_KV, HEAD_DIM).transpose(0, 2, 3, 1, 4)
    to_kv = lambda a: a.reshape(b_, s_, N_KV, HEAD_DIM).transpose(0, 2, 1, 3)
    k_cmp, v_cmp, k_slc, v_slc, k_win, v_win = [to_kv(a) for a in (k_cmp, v_cmp, k_slc, v_slc, k_win, v_win)]
    gates = jax.nn.sigmoid(g_nsa).reshape(b_, s_, N_KV, HEADS_PER_KV, 3).transpose(0, 2, 3, 1, 4)
    kc = compress(k_cmp, cmp_pos_k, cmp_k_w1, cmp_k_w2)
    vc = compress(v_cmp, cmp_pos_v, cmp_v_w1, cmp_v_w2)
    n_cmp = kc.shape[2]
    n_slc = s_ // SLC_BLOCK
    n_sel = min(N_SELECT, n_slc)
    ks_blk = k_slc.reshape(b_, N_KV, n_slc, SLC_BLOCK, HEAD_DIM)
    vs_blk = v_slc.reshape(b_, N_KV, n_slc, SLC_BLOCK, HEAD_DIM)
    pad = ((0, 0), (0, 0), (WINDOW, 0), (0, 0))
    kw_pad = jnp.pad(k_win, pad)
    vw_pad = jnp.pad(v_win, pad)
    slopes = jnp.asarray(alibi_slopes(N_HEADS)).reshape(N_KV, HEADS_PER_KV)[None, :, :, None, None]
    cmp_end = jnp.arange(n_cmp) * CMP_STRIDE + CMP_BLOCK - 1
    overlap = jnp.asarray(cmp_to_slc_overlap(n_cmp, n_slc))
    bi = jnp.arange(b_)[:, None, None, None]
    gi = jnp.arange(N_KV)[None, :, None, None]
    blk_ids = jnp.arange(n_slc)
    in_blk = jnp.arange(SLC_BLOCK)
    win_off = jnp.arange(WINDOW + Q_BLOCK) - WINDOW
    m_sel = n_sel * SLC_BLOCK

    def query_block(qb):
        q0 = qb * Q_BLOCK
        t = q0 + jnp.arange(Q_BLOCK)
        qq = lax.dynamic_slice_in_dim(q, q0, Q_BLOCK, axis=3)
        dist = (t[:, None] - cmp_end[None, :]).astype(f32)
        s = jnp.einsum('bghqd,bgnd->bghqn', qq, kc, preferred_element_type=f32)
        p_cmp = masked_softmax(s - slopes * dist, dist >= 0)
        o_cmp = jnp.einsum('bghqn,bgnd->bghqd', p_cmp.astype(dt), vc)
        imp = jnp.einsum('bghqn,nj->bgqj', p_cmp, overlap)
        cur = t // SLC_BLOCK
        forced = (blk_ids[None, :] == 0) | (blk_ids[None, :] == cur[:, None]) | (blk_ids[None, :] == cur[:, None] - 1)
        future = blk_ids[None, :] > cur[:, None]
        score = jnp.where(future, NEG, jnp.where(forced, FORCE, imp))
        _, idx = lax.top_k(score, n_sel)
        k_sel = ks_blk[bi, gi, idx].reshape(b_, N_KV, Q_BLOCK, m_sel, HEAD_DIM)
        v_sel = vs_blk[bi, gi, idx].reshape(b_, N_KV, Q_BLOCK, m_sel, HEAD_DIM)
        pos = (idx[..., None] * SLC_BLOCK + in_blk).reshape(b_, N_KV, Q_BLOCK, m_sel)
        dist = (t[:, None] - pos).astype(f32)[:, :, None]
        s = jnp.einsum('bghqd,bgqmd->bghqm', qq, k_sel, preferred_element_type=f32)
        p = masked_softmax(s - slopes * dist, dist >= 0)
        o_slc = jnp.einsum('bghqm,bgqmd->bghqd', p.astype(dt), v_sel)
        kw = lax.dynamic_slice_in_dim(kw_pad, q0, WINDOW + Q_BLOCK, axis=2)
        vw = lax.dynamic_slice_in_dim(vw_pad, q0, WINDOW + Q_BLOCK, axis=2)
        sp = q0 + win_off
        dist = t[:, None] - sp[None, :]
        valid = (dist >= 0) & (dist < WINDOW) & (sp[None, :] >= 0)
        s = jnp.einsum('bghqd,bgkd->bghqk', qq, kw, preferred_element_type=f32)
        p = masked_softmax(s - slopes * dist.astype(f32), valid)
        o_win = jnp.einsum('bghqk,bgkd->bghqd', p.astype(dt), vw)
        g = lax.dynamic_slice_in_dim(gates, q0, Q_BLOCK, axis=3)
        return g[..., 0:1] * o_cmp + g[..., 1:2] * o_slc + g[..., 2:3] * o_win

    out = lax.map(query_block, jnp.arange(s_ // Q_BLOCK))
    return out.transpose(1, 0, 4, 2, 3, 5).reshape(b_, s_, Q_WIDTH)


def token_mixer(h, w_mix_in, pool_w, pool_scale, cmp_pos_k, cmp_k_w1, cmp_k_w2, cmp_pos_v, cmp_v_w1, cmp_v_w2,
                w_branch_a, w_branch_b, w_mix_out):
    z = h @ w_mix_in
    splits = np.cumsum(MIX_SIZES)[:-1].tolist()
    u_pool, q, k_cmp, v_cmp, k_slc, v_slc, k_win, v_win, g_nsa, g_br = jnp.split(z, splits, axis=-1)
    y_a = pool_mixer(u_pool, pool_w, pool_scale) @ w_branch_a
    y_b = nsa_attention(q, k_cmp, v_cmp, k_slc, v_slc, k_win, v_win, g_nsa,
                        cmp_pos_k, cmp_k_w1, cmp_k_w2, cmp_pos_v, cmp_v_w1, cmp_v_w2) @ w_branch_b
    g_a, g_b = jnp.split(jax.nn.sigmoid(g_br), 2, axis=-1)
    return (g_a * y_a + g_b * y_b) @ w_mix_out


def setup_inputs(seed: int = 0) -> dict:
    key = jax.random.key(seed)
    keys = jax.random.split(key, 40)
    cnt = [0]

    def nrm(shape, scale):
        k = keys[cnt[0]]
        cnt[0] += 1
        return jax.random.normal(k, shape, jnp.float32) * scale

    L, D = DEPTH, D_MODEL
    col_scale = np.concatenate([np.full((n,), BETA if i in V_SLOTS else 1.0) for i, n in enumerate(MIX_SIZES)])
    col_scale = jnp.asarray((col_scale * D ** -0.5).astype(np.float32))
    return {
        'x': nrm((BATCH, SEQ, D), 1.0),
        'c': nrm((BATCH, D), 1.0),
        'ln_in_g': 1.0 + nrm((D,), 0.02),
        'ln_in_b': nrm((D,), 0.02),
        'w_ada': nrm((L, D, 9 * D), D ** -0.5),
        'b_ada': nrm((L, 9 * D), 0.02),
        'ffn1_w_in': nrm((L, D, 2 * D_FF), D ** -0.5),
        'ffn1_w_out': nrm((L, D_FF, D), BETA * D_FF ** -0.5),
        'ln1_g': 1.0 + nrm((L, D), 0.02),
        'ln1_b': nrm((L, D), 0.02),
        'w_mix_in': nrm((L, D, MIX_IN), 1.0) * col_scale,
        'pool_w': nrm((L, N_POOL_GROUPS, POOL_GROUP, POOL_GROUP), POOL_GROUP ** -0.5),
        'pool_scale': 1.0 + nrm((L, POOL_WIDTH), 0.1),
        'cmp_pos_k': nrm((L, CMP_BLOCK, HEAD_DIM), 0.02),
        'cmp_k_w1': nrm((L, CMP_BLOCK * HEAD_DIM, CMP_HIDDEN), (CMP_BLOCK * HEAD_DIM) ** -0.5),
        'cmp_k_w2': nrm((L, CMP_HIDDEN, HEAD_DIM), CMP_HIDDEN ** -0.5),
        'cmp_pos_v': nrm((L, CMP_BLOCK, HEAD_DIM), 0.02),
        'cmp_v_w1': nrm((L, CMP_BLOCK * HEAD_DIM, CMP_HIDDEN), (CMP_BLOCK * HEAD_DIM) ** -0.5),
        'cmp_v_w2': nrm((L, CMP_HIDDEN, HEAD_DIM), CMP_HIDDEN ** -0.5),
        'w_branch_a': nrm((L, POOL_WIDTH, D), BETA * POOL_WIDTH ** -0.5),
        'w_branch_b': nrm((L, Q_WIDTH, D), BETA * Q_WIDTH ** -0.5),
        'w_mix_out': nrm((L, D, D), BETA * D ** -0.5),
        'ln2_g': 1.0 + nrm((L, D), 0.02),
        'ln2_b': nrm((L, D), 0.02),
        'ffn2_w_in': nrm((L, D, 2 * D_FF), D ** -0.5),
        'ffn2_w_out': nrm((L, D_FF, D), BETA * D_FF ** -0.5),
        'ln3_g': 1.0 + nrm((L, D), 0.02),
        'ln3_b': nrm((L, D), 0.02),
    }


def reference(x, c, ln_in_g, ln_in_b, w_ada, b_ada, ffn1_w_in, ffn1_w_out, ln1_g, ln1_b,
              w_mix_in, pool_w, pool_scale, cmp_pos_k, cmp_k_w1, cmp_k_w2, cmp_pos_v, cmp_v_w1, cmp_v_w2,
              w_branch_a, w_branch_b, w_mix_out, ln2_g, ln2_b, ffn2_w_in, ffn2_w_out, ln3_g, ln3_b):
    x = layer_norm(x, ln_in_g, ln_in_b)
    c_act = jax.nn.silu(c)
    for l in range(DEPTH):
        ada = (c_act @ w_ada[l] + b_ada[l]).reshape(c.shape[0], 3, 3, D_MODEL)
        mod = lambda i, j: ada[:, i, j][:, None, :]
        h = x * (1.0 + mod(0, 1)) + mod(0, 0)
        x = layer_norm(ALPHA * x + 0.5 * mod(0, 2) * swiglu(h, ffn1_w_in[l], ffn1_w_out[l]), ln1_g[l], ln1_b[l])
        h = x * (1.0 + mod(1, 1)) + mod(1, 0)
        y = token_mixer(h, w_mix_in[l], pool_w[l], pool_scale[l], cmp_pos_k[l], cmp_k_w1[l], cmp_k_w2[l],
                        cmp_pos_v[l], cmp_v_w1[l], cmp_v_w2[l], w_branch_a[l], w_branch_b[l], w_mix_out[l])
        x = layer_norm(ALPHA * x + mod(1, 2) * y, ln2_g[l], ln2_b[l])
        h = x * (1.0 + mod(2, 1)) + mod(2, 0)
        x = layer_norm(ALPHA * x + 0.5 * mod(2, 2) * swiglu(h, ffn2_w_in[l], ffn2_w_out[l]), ln3_g[l], ln3_b[l])
    return x
```

```cpp
#include <hip/hip_runtime.h>
#include <hip/hip_cooperative_groups.h>
#include <cstdio>
#include <cstdint>
namespace cg = cooperative_groups;

#define LAS __attribute__((address_space(3)))
#define GAS __attribute__((address_space(1)))
typedef unsigned short bf16_t;
typedef short bf16x8 __attribute__((ext_vector_type(8)));
typedef float f32x4 __attribute__((ext_vector_type(4)));
typedef float f32x16 __attribute__((ext_vector_type(16)));
typedef unsigned u32x4 __attribute__((ext_vector_type(4)));
typedef unsigned u32x2 __attribute__((ext_vector_type(2)));

#ifndef MIXER_MODE
#define MIXER_MODE 2
#endif

constexpr int D = 1024, NBATCH = 16, SEQ = 4096, M = NBATCH * SEQ, DFF = 2816, NZ = 4096, NADA = 9 * D;
constexpr float ALPHA = 1.189207115002721f;
constexpr float LN_EPS = 1e-5f;
constexpr float LOG2E = 1.4426950408889634f;
constexpr int ZC_Q = 512, ZC_KCMP = 1024, ZC_VCMP = 1152, ZC_KSLC = 1280, ZC_VSLC = 1408, ZC_KWIN = 1536, ZC_VWIN = 1664, ZC_GNSA = 1792, ZC_GA = 2048, ZC_GB = 3072;

constexpr size_t MiB = 1u << 20;
constexpr size_t WS_ADA = 1 * MiB;
constexpr size_t WS_W1IN = 2 * MiB;
constexpr size_t WS_W1OUT = 13 * MiB;
constexpr size_t WS_W2IN = 19 * MiB;
constexpr size_t WS_W2OUT = 30 * MiB;
constexpr size_t WS_WMIX = 36 * MiB;
constexpr size_t WS_WA = 44 * MiB;
constexpr size_t WS_WB = 45 * MiB;
constexpr size_t WS_WMO = 46 * MiB;
constexpr size_t WS_CKW1 = 48 * MiB;
constexpr size_t WS_CVW1 = 49 * MiB;
constexpr size_t WS_CKW2 = 50 * MiB;
constexpr size_t WS_CVW2 = 50 * MiB + 512 * 1024;
constexpr size_t WS_KC = 51 * MiB;
constexpr size_t WS_VCT = 52 * MiB;
constexpr size_t WS_HIDK = 53 * MiB;
constexpr size_t WS_HIDV = 57 * MiB;
constexpr size_t WS_VTS = 64 * MiB;
constexpr size_t WS_VTW = 80 * MiB;
constexpr size_t WS_H = 96 * MiB;
constexpr size_t WS_DELTA = 224 * MiB;
constexpr size_t WS_O = 288 * MiB;
constexpr size_t WS_ACT = 352 * MiB;
constexpr size_t WS_KBLK = 864 * MiB;
constexpr size_t WS_VBLK = 896 * MiB;
constexpr size_t WS_END = 928 * MiB;

constexpr int LDS_BYTES = 147456;

__device__ __forceinline__ unsigned cvt_pk_bf16(float lo, float hi) { unsigned r; asm("v_cvt_pk_bf16_f32 %0, %1, %2" : "=v"(r) : "v"(lo), "v"(hi)); return r; }
__device__ __forceinline__ float bf_lo(unsigned u) { return __uint_as_float(u << 16); }
__device__ __forceinline__ float bf_hi(unsigned u) { return __uint_as_float(u & 0xffff0000u); }
__device__ __forceinline__ float fast_rcp(float x) { return __builtin_amdgcn_rcpf(x); }
__device__ __forceinline__ float fast_exp2(float x) { return __builtin_amdgcn_exp2f(x); }
__device__ __forceinline__ float sigmoidf_(float x) { return fast_rcp(1.0f + fast_exp2(-x * LOG2E)); }
__device__ __forceinline__ float siluf_(float x) { return x * sigmoidf_(x); }
__device__ __forceinline__ float gelu_tanh(float x) { const float u = 0.7978845608028654f * (x + 0.044715f * x * x * x); const float e = fast_exp2(2.0f * LOG2E * u); const float th = 1.0f - 2.0f * fast_rcp(e + 1.0f); return 0.5f * x * (1.0f + th); }
#define LDS_WAIT() asm volatile("s_waitcnt lgkmcnt(0)" ::: "memory")

namespace pg8 {
constexpr int BM = 256, BK = 64, HALF = 128, HTB = HALF * BK * 2, STAGE_BYTES = 8 * HTB, NXCD = 8, WGM = 8;
__host__ __device__ __forceinline__ int lds_byte(int r, int c) { const int st = (r >> 4) * 2 + (c >> 5), rr = r & 15, cc = c & 31, ob = rr * 64 + cc * 2; return st * 1024 + (ob ^ (((ob >> 9) & 1) << 5)); }
__host__ __device__ __forceinline__ void stage_rc(int b, int& R, int& C) { const int st = b / 1024, sb = b % 1024, swz = sb ^ (((sb >> 9) & 1) << 5); R = (st >> 1) * 16 + swz / 64; C = (st & 1) * 32 + (swz % 64) / 2; }
__host__ __device__ __forceinline__ int perm32(int rho) { const int n = rho >> 4, i = rho & 15; return 8 * (i >> 2) + 4 * n + (i & 3); }

struct Unit { int pm, pn; };
struct Gemm { GAS const bf16_t* A; GAS const bf16_t* Bt; int M, N, K, lda, ldb; };

struct StaticOrder {
    int nM, nN, nwg, G, c;
    __device__ void init(int M_, int N_, int G_, int c_) { nM = M_ / BM; nN = N_ / BM; nwg = nM * nN; G = G_; c = c_; }
    __device__ bool next(int i, Unit& u) const {
        const long L = (long)i * G + c; if (L >= nwg) return false;
        int wgid = (int)L; { const int q = nwg / NXCD, r = nwg % NXCD, xcd = wgid % NXCD, off = wgid / NXCD; wgid = (xcd < r ? xcd * (q + 1) : r * (q + 1) + (xcd - r) * q) + off; }
        const int nig = WGM * nN, gid = wgid / nig, fm = gid * WGM, gsz = (nM - fm) < WGM ? (nM - fm) : WGM;
        u.pm = fm + ((wgid % nig) % gsz); u.pn = (wgid % nig) / gsz; return true;
    }
};

template <class Epi>
__device__ __forceinline__ void gemm_phase(LAS unsigned char* lds, const Gemm g, const StaticOrder& S, const Epi& E) {
    int tid_ = threadIdx.x; asm volatile("" : "+v"(tid_));
    const int tid = tid_, wid = __builtin_amdgcn_readfirstlane(tid >> 6), lane = tid & 63, wr = wid >> 2, wc = wid & 3, fr = lane & 15, fq = lane >> 4;
    const int K = g.K, nt = K / BK;
    unsigned voffA[2], voffB[2];
#pragma unroll
    for (int i = 0; i < 2; ++i) { int R, C; stage_rc(tid * 16 + i * 8192, R, C); const int Rb = Epi::PERM ? ((R & ~31) + perm32(R & 31)) : R;
        voffA[i] = (unsigned)(R * g.lda + C) * 2u; voffB[i] = (unsigned)(Rb * g.ldb + C) * 2u; }
    const size_t kstep = (size_t)(BK * 2);
    const size_t hstepA = (size_t)HALF * g.lda * 2, hstepB = (size_t)HALF * g.ldb * 2;
    const size_t tstepA = 2 * hstepA, tstepB = 2 * hstepB;
    const unsigned ldsw = (unsigned)wid * 1024u;
    const int aoff = lds_byte(wr * 64 + fr, fq * 8), boff = lds_byte(wc * 32 + fr, fq * 8);
#define PG8_SA(b, h) (((b) * 2 + (h)) * HTB)
#define PG8_SB(b, h) ((4 + (b) * 2 + (h)) * HTB)
#define PG8_STAGE(bufoff, gbase, voff) do { _Pragma("unroll") for (int _i = 0; _i < 2; ++_i) \
        __builtin_amdgcn_global_load_lds((GAS const unsigned*)((gbase) + (voff)[_i]), (LAS unsigned*)(lds + (bufoff) + ldsw + _i * 8192), 16, 0, 0); } while (0)
#define PG8_LDA(dst, b, h) do { _Pragma("unroll") for (int m = 0; m < 4; ++m) _Pragma("unroll") for (int k = 0; k < 2; ++k) dst[m][k] = *(const LAS bf16x8*)(lds + PG8_SA(b, h) + aoff + m * 2048 + k * 1024); } while (0)
#define PG8_LDB(dst, b, h) do { _Pragma("unroll") for (int n = 0; n < 2; ++n) _Pragma("unroll") for (int k = 0; k < 2; ++k) dst[n][k] = *(const LAS bf16x8*)(lds + PG8_SB(b, h) + boff + n * 2048 + k * 1024); } while (0)
#define PG8_MMA(ai, bj, At, Bt) do { __builtin_amdgcn_s_setprio(1); _Pragma("unroll") for (int m = 0; m < 4; ++m) _Pragma("unroll") for (int n = 0; n < 2; ++n) _Pragma("unroll") for (int k = 0; k < 2; ++k) \
        acc[ai][bj][m][n] = __builtin_amdgcn_mfma_f32_16x16x32_bf16(Bt[n][k], At[m][k], acc[ai][bj][m][n], 0, 0, 0); __builtin_amdgcn_s_setprio(0); } while (0)
#define PG8_WAIT_V(n) asm volatile("s_waitcnt vmcnt(" #n ")" ::: "memory")
#define PG8_WAIT_L(n) asm volatile("s_waitcnt lgkmcnt(" #n ")" ::: "memory")
#define PG8_BAR __builtin_amdgcn_s_barrier()
#define PG8_SCHED __builtin_amdgcn_sched_barrier(0)
    Unit cur, nxt; int ui = 0;
    if (!S.next(0, cur)) return;
    f32x4 acc[2][2][4][2];
#pragma unroll
    for (int a = 0; a < 2; ++a)
#pragma unroll
        for (int b = 0; b < 2; ++b)
#pragma unroll
            for (int m = 0; m < 4; ++m)
#pragma unroll
                for (int n = 0; n < 2; ++n) acc[a][b][m][n] = (f32x4){0.f, 0.f, 0.f, 0.f};
    bf16x8 At[4][2], B0[2][2], B1[2][2];
    GAS const char* cA = (GAS const char*)g.A + (size_t)cur.pm * tstepA; GAS const char* cB = (GAS const char*)g.Bt + (size_t)cur.pn * tstepB;
    PG8_STAGE(PG8_SB(0, 0), cB, voffB); PG8_STAGE(PG8_SB(0, 1), cB + hstepB, voffB); PG8_STAGE(PG8_SA(0, 0), cA, voffA); PG8_STAGE(PG8_SA(0, 1), cA + hstepA, voffA);
    if (wr == 1) PG8_BAR;
    PG8_WAIT_V(2); PG8_BAR;
    PG8_STAGE(PG8_SB(1, 0), cB + kstep, voffB); PG8_STAGE(PG8_SA(1, 0), cA + kstep, voffA); PG8_STAGE(PG8_SB(1, 1), cB + hstepB + kstep, voffB);
    PG8_WAIT_V(6); PG8_BAR;
    for (;;) {
        const bool has_next = S.next(ui + 1, nxt);
        GAS const char* nA = has_next ? (GAS const char*)g.A + (size_t)nxt.pm * tstepA : cA; GAS const char* nB = has_next ? (GAS const char*)g.Bt + (size_t)nxt.pn * tstepB : cB;
        for (int t = 0; t < nt; t += 2) {
            const bool last = (t == nt - 2);
            GAS const char* a1 = cA + (size_t)(t + 1) * kstep;
            GAS const char* a2 = last ? nA : cA + (size_t)(t + 2) * kstep; GAS const char* b2 = last ? nB : cB + (size_t)(t + 2) * kstep;
            GAS const char* a3 = a2 + kstep; GAS const char* b3 = b2 + kstep;
            PG8_LDB(B0, 0, 0); PG8_LDB(B1, 0, 1); PG8_SCHED; PG8_LDA(At, 0, 0); PG8_STAGE(PG8_SA(1, 1), a1 + hstepA, voffA);
            PG8_WAIT_V(8); PG8_WAIT_L(0); PG8_BAR; PG8_MMA(0, 0, At, B0); PG8_MMA(0, 1, At, B1); PG8_BAR; PG8_SCHED;
            PG8_LDA(At, 0, 1); PG8_STAGE(PG8_SB(0, 0), b2, voffB); PG8_STAGE(PG8_SB(0, 1), b2 + hstepB, voffB); PG8_STAGE(PG8_SA(0, 0), a2, voffA);
            PG8_WAIT_V(8); PG8_WAIT_L(0); PG8_BAR; PG8_MMA(1, 0, At, B0); PG8_MMA(1, 1, At, B1); PG8_BAR; PG8_SCHED;
            PG8_LDB(B0, 1, 0); PG8_LDB(B1, 1, 1); PG8_SCHED; PG8_LDA(At, 1, 0); PG8_STAGE(PG8_SA(0, 1), a2 + hstepA, voffA);
            PG8_WAIT_V(8); PG8_WAIT_L(0); PG8_BAR; PG8_MMA(0, 0, At, B0); PG8_MMA(0, 1, At, B1); PG8_BAR; PG8_SCHED;
            PG8_LDA(At, 1, 1); PG8_STAGE(PG8_SB(1, 0), b3, voffB); PG8_STAGE(PG8_SB(1, 1), b3 + hstepB, voffB); PG8_STAGE(PG8_SA(1, 0), a3, voffA);
            PG8_WAIT_V(8); PG8_WAIT_L(0); PG8_BAR; PG8_MMA(1, 0, At, B0); PG8_MMA(1, 1, At, B1); PG8_BAR; PG8_SCHED;
        }
        if (wr == 0) PG8_BAR;
        E(acc, cur, wr, wc, fr, fq);
        if (!has_next) break;
#pragma unroll
        for (int a = 0; a < 2; ++a)
#pragma unroll
            for (int b = 0; b < 2; ++b)
#pragma unroll
                for (int m = 0; m < 4; ++m)
#pragma unroll
                    for (int n = 0; n < 2; ++n) acc[a][b][m][n] = (f32x4){0.f, 0.f, 0.f, 0.f};
        cur = nxt; cA = nA; cB = nB; ++ui;
        if (wr == 1) PG8_BAR;
    }
    PG8_WAIT_V(0);
    PG8_BAR;
#undef PG8_SA
#undef PG8_SB
#undef PG8_STAGE
#undef PG8_LDA
#undef PG8_LDB
#undef PG8_MMA
#undef PG8_WAIT_V
#undef PG8_WAIT_L
#undef PG8_BAR
#undef PG8_SCHED
}

typedef const f32x4 (&AccRef)[2][2][4][2];

struct EpiSwiglu {
    static constexpr bool PERM = true;
    GAS bf16_t* O;
    __device__ __forceinline__ void operator()(AccRef acc, const Unit& u, int wr, int wc, int fr, int fq) const {
        const int row0 = u.pm * BM + wr * 64 + fr, col0 = u.pn * HALF + wc * 32 + 8 * fq;
#pragma unroll
        for (int ai = 0; ai < 2; ++ai)
#pragma unroll
            for (int m = 0; m < 4; ++m) {
                GAS bf16_t* rowp = O + (size_t)(row0 + ai * HALF + m * 16) * DFF + col0;
                const f32x4 g0 = acc[ai][0][m][0], g1 = acc[ai][0][m][1], u0 = acc[ai][1][m][0], u1 = acc[ai][1][m][1];
                u32x4 w;
                w.x = cvt_pk_bf16(siluf_(g0[0]) * u0[0], siluf_(g0[1]) * u0[1]); w.y = cvt_pk_bf16(siluf_(g0[2]) * u0[2], siluf_(g0[3]) * u0[3]);
                w.z = cvt_pk_bf16(siluf_(g1[0]) * u1[0], siluf_(g1[1]) * u1[1]); w.w = cvt_pk_bf16(siluf_(g1[2]) * u1[2], siluf_(g1[3]) * u1[3]);
                *(GAS u32x4*)rowp = w;
            }
    }
};

struct EpiY {
    static constexpr bool PERM = true;
    GAS bf16_t* Y; GAS const float* gate; float coef;
    __device__ __forceinline__ void operator()(AccRef acc, const Unit& u, int wr, int wc, int fr, int fq) const {
        const int row0 = u.pm * BM + wr * 64 + fr, col0 = u.pn * BM + wc * 32 + 8 * fq;
        GAS const float* gp = gate + (size_t)(u.pm >> 4) * NADA + col0;
        f32x4 gv[2][2];
#pragma unroll
        for (int bj = 0; bj < 2; ++bj)
#pragma unroll
            for (int n = 0; n < 2; ++n) gv[bj][n] = *(GAS const f32x4*)(gp + bj * HALF + n * 4) * coef;
#pragma unroll
        for (int ai = 0; ai < 2; ++ai)
#pragma unroll
            for (int m = 0; m < 4; ++m) {
                GAS bf16_t* rowp = Y + (size_t)(row0 + ai * HALF + m * 16) * D + col0;
#pragma unroll
                for (int bj = 0; bj < 2; ++bj) {
                    const f32x4 v0 = acc[ai][bj][m][0] * gv[bj][0], v1 = acc[ai][bj][m][1] * gv[bj][1];
                    u32x4 w; w.x = cvt_pk_bf16(v0[0], v0[1]); w.y = cvt_pk_bf16(v0[2], v0[3]); w.z = cvt_pk_bf16(v1[0], v1[1]); w.w = cvt_pk_bf16(v1[2], v1[3]);
                    *(GAS u32x4*)(rowp + bj * HALF) = w;
                }
            }
    }
};

struct EpiZ {
    static constexpr bool PERM = true;
    GAS bf16_t* Z;
    __device__ __forceinline__ void operator()(AccRef acc, const Unit& u, int wr, int wc, int fr, int fq) const {
        const int row0 = u.pm * BM + wr * 64 + fr, col0 = u.pn * BM + wc * 32 + 8 * fq;
        const bool sg = u.pn >= 7;
#pragma unroll
        for (int ai = 0; ai < 2; ++ai)
#pragma unroll
            for (int m = 0; m < 4; ++m) {
                GAS bf16_t* rowp = Z + (size_t)(row0 + ai * HALF + m * 16) * NZ + col0;
#pragma unroll
                for (int bj = 0; bj < 2; ++bj) {
                    f32x4 v0 = acc[ai][bj][m][0], v1 = acc[ai][bj][m][1];
                    if (sg) {
#pragma unroll
                        for (int j = 0; j < 4; ++j) { v0[j] = sigmoidf_(v0[j]); v1[j] = sigmoidf_(v1[j]); }
                    }
                    u32x4 w; w.x = cvt_pk_bf16(v0[0], v0[1]); w.y = cvt_pk_bf16(v0[2], v0[3]); w.z = cvt_pk_bf16(v1[0], v1[1]); w.w = cvt_pk_bf16(v1[2], v1[3]);
                    *(GAS u32x4*)(rowp + bj * HALF) = w;
                }
            }
    }
};

struct EpiGate {
    static constexpr bool PERM = true;
    GAS const bf16_t* Z; GAS bf16_t* MX; int goff; int add;
    __device__ __forceinline__ void operator()(AccRef acc, const Unit& u, int wr, int wc, int fr, int fq) const {
        const int row0 = u.pm * BM + wr * 64 + fr, col0 = u.pn * BM + wc * 32 + 8 * fq;
#pragma unroll
        for (int ai = 0; ai < 2; ++ai)
#pragma unroll
            for (int m = 0; m < 4; ++m) {
                const size_t row = (size_t)(row0 + ai * HALF + m * 16);
#pragma unroll
                for (int bj = 0; bj < 2; ++bj) {
                    const u32x4 gz = *(GAS const u32x4*)(Z + row * NZ + goff + col0 + bj * HALF);
                    GAS bf16_t* op = MX + row * D + col0 + bj * HALF;
                    const f32x4 v0 = acc[ai][bj][m][0], v1 = acc[ai][bj][m][1];
                    float r[8];
                    r[0] = bf_lo(gz.x) * v0[0]; r[1] = bf_hi(gz.x) * v0[1]; r[2] = bf_lo(gz.y) * v0[2]; r[3] = bf_hi(gz.y) * v0[3];
                    r[4] = bf_lo(gz.z) * v1[0]; r[5] = bf_hi(gz.z) * v1[1]; r[6] = bf_lo(gz.w) * v1[2]; r[7] = bf_hi(gz.w) * v1[3];
                    if (add) { const u32x4 pv = *(GAS const u32x4*)op;
                        r[0] += bf_lo(pv.x); r[1] += bf_hi(pv.x); r[2] += bf_lo(pv.y); r[3] += bf_hi(pv.y); r[4] += bf_lo(pv.z); r[5] += bf_hi(pv.z); r[6] += bf_lo(pv.w); r[7] += bf_hi(pv.w); }
                    u32x4 w; w.x = cvt_pk_bf16(r[0], r[1]); w.y = cvt_pk_bf16(r[2], r[3]); w.z = cvt_pk_bf16(r[4], r[5]); w.w = cvt_pk_bf16(r[6], r[7]);
                    *(GAS u32x4*)op = w;
                }
            }
    }
};

struct EpiCmp1 {
    static constexpr bool PERM = true;
    GAS bf16_t* Hd;
    __device__ __forceinline__ void operator()(AccRef acc, const Unit& u, int wr, int wc, int fr, int fq) const {
        const int row0 = u.pm * BM + wr * 64 + fr, col0 = wc * 32 + 8 * fq;
#pragma unroll
        for (int ai = 0; ai < 2; ++ai)
#pragma unroll
            for (int m = 0; m < 4; ++m) {
                GAS bf16_t* rowp = Hd + (size_t)(row0 + ai * HALF + m * 16) * 256 + col0;
#pragma unroll
                for (int bj = 0; bj < 2; ++bj) {
                    const f32x4 v0 = acc[ai][bj][m][0], v1 = acc[ai][bj][m][1];
                    u32x4 w; w.x = cvt_pk_bf16(gelu_tanh(v0[0]), gelu_tanh(v0[1])); w.y = cvt_pk_bf16(gelu_tanh(v0[2]), gelu_tanh(v0[3]));
                    w.z = cvt_pk_bf16(gelu_tanh(v1[0]), gelu_tanh(v1[1])); w.w = cvt_pk_bf16(gelu_tanh(v1[2]), gelu_tanh(v1[3]));
                    *(GAS u32x4*)(rowp + bj * HALF) = w;
                }
            }
    }
};

struct EpiCmp2 {
    static constexpr bool PERM = true;
    GAS bf16_t* out; int tr;
    __device__ __forceinline__ void operator()(AccRef acc, const Unit& u, int wr, int wc, int fr, int fq) const {
        if (wc >= 2) return;
        const int row0 = u.pm * BM + wr * 64 + fr, col0 = wc * 32 + 8 * fq;
#pragma unroll
        for (int ai = 0; ai < 2; ++ai)
#pragma unroll
            for (int m = 0; m < 4; ++m) {
                const int row = row0 + ai * HALF + m * 16;
                const f32x4 v0 = acc[ai][0][m][0], v1 = acc[ai][0][m][1];
                u32x4 w; w.x = cvt_pk_bf16(v0[0], v0[1]); w.y = cvt_pk_bf16(v0[2], v0[3]); w.z = cvt_pk_bf16(v1[0], v1[1]); w.w = cvt_pk_bf16(v1[2], v1[3]);
                if (!tr) { *(GAS u32x4*)(out + (size_t)row * 64 + col0) = w; }
                else {
                    GAS bf16_t* base = out + ((size_t)(row >> 8) * 64 + col0) * 256 + (row & 255);
                    base[0 * 256] = (bf16_t)(w.x & 0xffffu); base[1 * 256] = (bf16_t)(w.x >> 16); base[2 * 256] = (bf16_t)(w.y & 0xffffu); base[3 * 256] = (bf16_t)(w.y >> 16);
                    base[4 * 256] = (bf16_t)(w.z & 0xffffu); base[5 * 256] = (bf16_t)(w.z >> 16); base[6 * 256] = (bf16_t)(w.w & 0xffffu); base[7 * 256] = (bf16_t)(w.w >> 16);
                }
            }
    }
};
}

__device__ __forceinline__ float wave_sum(float v) {
#pragma unroll
    for (int o = 1; o < 64; o <<= 1) v += __shfl_xor(v, o);
    return v;
}

__device__ __forceinline__ void tr_item(GAS const float* __restrict__ W, int N, GAS bf16_t* WT, int ldd, int map, LAS float* scr, int item, int nblk, int lane) {
    const int kb = item / nblk, nb = item % nblk, k0 = 64 * kb, n0 = 32 * nb;
    const int nd = n0 + (lane & 31);
    int sc;
    if (map == 0) sc = nd;
    else if (map == 1) { const int t = nd >> 8, r = nd & 255; sc = r < 128 ? 128 * t + r : DFF + 128 * t + (r - 128); }
    else if (map == 2) sc = nd < 1816 ? nd : (nd < 2048 ? -1 : nd - 232);
    else sc = nd < 64 ? nd : -1;
#pragma unroll
    for (int i = 0; i < 32; ++i) { const int kk = 2 * i + (lane >> 5); scr[kk * 33 + (lane & 31)] = sc >= 0 ? W[(size_t)(k0 + kk) * N + sc] : 0.f; }
    LDS_WAIT(); asm volatile("" ::: "memory");
    const int c = lane & 7;
#pragma unroll
    for (int j = 0; j < 4; ++j) { const int n = (lane >> 3) + 8 * j; const LAS float* s = scr + (8 * c) * 33 + n;
        u32x4 o; o.x = cvt_pk_bf16(s[0 * 33], s[1 * 33]); o.y = cvt_pk_bf16(s[2 * 33], s[3 * 33]); o.z = cvt_pk_bf16(s[4 * 33], s[5 * 33]); o.w = cvt_pk_bf16(s[6 * 33], s[7 * 33]);
        *(GAS u32x4*)(WT + (size_t)(n0 + n) * ldd + k0 + 8 * c) = o; }
    LDS_WAIT(); asm volatile("" ::: "memory");
}

template <bool WRITE_X, bool WRITE_H, bool ADD_Y, bool PRE_LN>
__device__ __forceinline__ void ln_rows(GAS const float* src, GAS const bf16_t* Y, GAS float* X, GAS bf16_t* H, GAS const float* __restrict__ lg, GAS const float* __restrict__ lb, GAS const float* ada, int modi,
                                        GAS const float* __restrict__ pg, GAS const float* __restrict__ pb, int gw, int NGW, int lane) {
    for (int row0 = 2 * gw; row0 < M; row0 += 2 * NGW) {
        f32x4 v[2][4]; u32x2 yv[2][4];
#pragma unroll
        for (int rr = 0; rr < 2; ++rr) {
            const int row = row0 + rr;
            GAS const f32x4* xr = (GAS const f32x4*)(src + (size_t)row * D) + lane;
#pragma unroll
            for (int j = 0; j < 4; ++j) {
                v[rr][j] = xr[64 * j];
                if (ADD_Y) yv[rr][j] = ((GAS const u32x2*)(Y + (size_t)row * D) + lane)[64 * j];
            }
        }
#pragma unroll
        for (int rr = 0; rr < 2; ++rr) {
            const int row = row0 + rr;
            if (PRE_LN) {
                float s = 0.f;
#pragma unroll
                for (int j = 0; j < 4; ++j) s += (v[rr][j].x + v[rr][j].y) + (v[rr][j].z + v[rr][j].w);
                const float mean = wave_sum(s) * (1.f / D); float s2 = 0.f;
#pragma unroll
                for (int j = 0; j < 4; ++j) { v[rr][j] = v[rr][j] - mean; s2 += (v[rr][j].x * v[rr][j].x + v[rr][j].y * v[rr][j].y) + (v[rr][j].z * v[rr][j].z + v[rr][j].w * v[rr][j].w); }
                const float rstd = 1.f / sqrtf(wave_sum(s2) * (1.f / D) + LN_EPS);
#pragma unroll
                for (int j = 0; j < 4; ++j) { const int col = 4 * lane + 256 * j; v[rr][j] = v[rr][j] * rstd * *(GAS const f32x4*)(pg + col) + *(GAS const f32x4*)(pb + col); }
            }
            float s = 0.f;
#pragma unroll
            for (int j = 0; j < 4; ++j) {
                if (ADD_Y) { const u32x2 y = yv[rr][j]; v[rr][j] = v[rr][j] * ALPHA + (f32x4){bf_lo(y.x), bf_hi(y.x), bf_lo(y.y), bf_hi(y.y)}; }
                s += (v[rr][j].x + v[rr][j].y) + (v[rr][j].z + v[rr][j].w);
            }
            const float mean = wave_sum(s) * (1.f / D); float s2 = 0.f;
#pragma unroll
            for (int j = 0; j < 4; ++j) { v[rr][j] = v[rr][j] - mean; s2 += (v[rr][j].x * v[rr][j].x + v[rr][j].y * v[rr][j].y) + (v[rr][j].z * v[rr][j].z + v[rr][j].w * v[rr][j].w); }
            const float rstd = 1.f / sqrtf(wave_sum(s2) * (1.f / D) + LN_EPS);
            GAS const float* ab = ada + (size_t)(row >> 12) * NADA + (size_t)modi * 3 * D;
            GAS f32x4* xo = (GAS f32x4*)(X + (size_t)row * D) + lane;
            GAS u32x2* ho = (GAS u32x2*)(H + (size_t)row * D) + lane;
#pragma unroll
            for (int j = 0; j < 4; ++j) {
                const int col = 4 * lane + 256 * j;
                const f32x4 gg = *(GAS const f32x4*)(lg + col), bb = *(GAS const f32x4*)(lb + col);
                const f32x4 y = v[rr][j] * rstd * gg + bb;
                if (WRITE_X) xo[64 * j] = y;
                if (WRITE_H) {
                    const f32x4 sh = *(GAS const f32x4*)(ab + col), sc = *(GAS const f32x4*)(ab + D + col);
                    const f32x4 h = y * (sc + 1.0f) + sh;
                    u32x2 w; w.x = cvt_pk_bf16(h.x, h.y); w.y = cvt_pk_bf16(h.z, h.w);
                    ho[64 * j] = w;
                }
            }
        }
    }
}

namespace att {
constexpr int SLOT_BYTES = 16384, NSLOT = 3;
constexpr int OFF_IMP = NSLOT * SLOT_BYTES;
constexpr int IMP_PITCH = 65;
constexpr int OFF_SCORE = OFF_IMP + 4 * 64 * IMP_PITCH * 4;
constexpr int OFF_SEL = OFF_SCORE + 64 * IMP_PITCH * 4;
constexpr int OFF_UN = OFF_SEL + 512;
constexpr int OFF_LIST = OFF_UN + 16;
constexpr float NEGV = -1e30f;
constexpr float C2 = 0.125f * LOG2E;

struct Src { GAS const bf16_t* k; GAS const bf16_t* v; int kpitch, vpitch; };

template <int MODE, bool INTERIOR>
__device__ __forceinline__ void tile_compute(const LAS unsigned char* Kb, const LAS unsigned char* Vb, const bf16x8 (&qf)[4], f32x16 (&o)[2], float& m, float& l, float inv_l,
                                             int tile, int t, float slope2, bool selbit, int qb, int ql, int hh, float (&prim)[8], float& carry) {
    const int swz4 = ((ql >> 1) & 7) << 4;
    bf16x8 kf[4][2];
#pragma unroll
    for (int ds = 0; ds < 4; ++ds) {
        kf[ds][0] = *(const LAS bf16x8*)(Kb + ql * 128 + (((ds * 2 + hh) << 4) ^ swz4));
        kf[ds][1] = *(const LAS bf16x8*)(Kb + (32 + ql) * 128 + (((ds * 2 + hh) << 4) ^ swz4));
    }
    __builtin_amdgcn_sched_barrier(0);
    f32x16 s[2];
    if (INTERIOR) {
        const float slopeC = slope2 * (1.0f / C2) * (MODE <= 1 ? 16.f : 1.f);
        float b0C = (MODE <= 1) ? slope2 * (1.0f / C2) * (float)(16 * (tile * 64 + 4 * hh) + 31 - t) : slopeC * (float)(tile * 64 + 4 * hh - t);
        if (MODE == 2 && !selbit) b0C = NEGV;
#pragma unroll
        for (int sub = 0; sub < 2; ++sub)
#pragma unroll
            for (int i = 0; i < 16; ++i) s[sub][i] = __builtin_fmaf(slopeC, (float)(sub * 32 + (i & 3) + 8 * (i >> 2)), b0C);
    } else {
#pragma unroll
        for (int i = 0; i < 16; ++i) { s[0][i] = 0.f; s[1][i] = 0.f; }
    }
#pragma unroll
    for (int ds = 0; ds < 4; ++ds) {
        s[0] = __builtin_amdgcn_mfma_f32_32x32x16_bf16(kf[ds][0], qf[ds], s[0], 0, 0, 0);
        s[1] = __builtin_amdgcn_mfma_f32_32x32x16_bf16(kf[ds][1], qf[ds], s[1], 0, 0, 0);
    }
    constexpr bool VPRE = INTERIOR && MODE >= 2;
    u32x2 vlo[4][2], vhi[4][2];
    if (VPRE) {
#pragma unroll
        for (int ks = 0; ks < 4; ++ks)
#pragma unroll
            for (int dsub = 0; dsub < 2; ++dsub) {
                const LAS unsigned char* vrow = Vb + (dsub * 32 + ql) * 128 + hh * 8;
                vlo[ks][dsub] = *(const LAS u32x2*)(vrow + (((ks * 2) << 4) ^ swz4)); vhi[ks][dsub] = *(const LAS u32x2*)(vrow + (((ks * 2 + 1) << 4) ^ swz4));
            }
        __builtin_amdgcn_sched_barrier(0);
    }
    float mx = NEGV;
    if (INTERIOR) {
#pragma unroll
        for (int sub = 0; sub < 2; ++sub)
#pragma unroll
            for (int i = 0; i < 16; ++i) { const float sv = s[sub][i] * C2; s[sub][i] = sv; mx = fmaxf(mx, sv); }
    } else {
        __builtin_amdgcn_sched_barrier(0);
        const float base = (MODE <= 1) ? (float)(t - 31 - 16 * (tile * 64 + 4 * hh)) : (float)(t - tile * 64 - 4 * hh);
        const float step = (MODE <= 1) ? 16.f : 1.f;
        const float nslope = -slope2;
#pragma unroll
        for (int sub = 0; sub < 2; ++sub)
#pragma unroll
            for (int i = 0; i < 16; ++i) {
                const float cpos = (float)(sub * 32 + (i & 3) + 8 * (i >> 2));
                const float dist = base - step * cpos;
                bool valid = dist >= 0.f;
                if (MODE == 2) valid = valid && selbit;
                if (MODE == 3) valid = valid && dist < 512.f;
                const float sv = valid ? __builtin_fmaf(s[sub][i], C2, nslope * dist) : NEGV;
                s[sub][i] = sv; mx = fmaxf(mx, sv);
            }
    }
    if (MODE != 1) {
        mx = fmaxf(mx, __shfl_xor(mx, 32));
        const float mn = fmaxf(m, mx);
        float rs = 0.f;
#pragma unroll
        for (int sub = 0; sub < 2; ++sub)
#pragma unroll
            for (int i = 0; i < 16; ++i) { const float sv = s[sub][i]; const float p = INTERIOR ? fast_exp2(sv - mn) : (sv > -1e29f ? fast_exp2(sv - mn) : 0.f); s[sub][i] = p; rs += p; }
        rs += __shfl_xor(rs, 32);
        if (__builtin_amdgcn_ballot_w64(mn > m) != 0ull) {
            const float alpha = fast_exp2(m - mn);
            l *= alpha;
            if (MODE != 0) {
#pragma unroll
                for (int i = 0; i < 16; ++i) { o[0][i] *= alpha; o[1][i] *= alpha; }
            }
        }
        l += rs; m = mn;
    } else {
#pragma unroll
        for (int sub = 0; sub < 2; ++sub)
#pragma unroll
            for (int i = 0; i < 16; ++i) { const float sv = s[sub][i]; s[sub][i] = (INTERIOR || sv > -1e29f) ? fast_exp2(sv - m) * inv_l : 0.f; }
        float sp[8];
#pragma unroll
        for (int k = 0; k < 8; ++k) { const int sub = k >> 2, i0 = (k & 3) * 4; prim[k] = (s[sub][i0] + s[sub][i0 + 1]) + (s[sub][i0 + 2] + s[sub][i0 + 3]); sp[k] = s[sub][i0 + 3]; }
        float x[8];
#pragma unroll
        for (int k = 0; k < 8; ++k) x[k] = __shfl_xor(sp[k], 32);
#pragma unroll
        for (int k = 0; k < 8; ++k) { const float fromlow = (k > 0) ? x[k > 0 ? k - 1 : 0] : carry; prim[k] += hh ? x[k] : fromlow; }
        carry = x[7];
    }
    if (MODE != 0) {
#pragma unroll
        for (int ks = 0; ks < 4; ++ks) {
            const int sub = ks >> 1, i0 = (ks & 1) * 8;
            union { u32x4 u; bf16x8 b; } pk;
            pk.u.x = cvt_pk_bf16(s[sub][i0 + 0], s[sub][i0 + 1]); pk.u.y = cvt_pk_bf16(s[sub][i0 + 2], s[sub][i0 + 3]);
            pk.u.z = cvt_pk_bf16(s[sub][i0 + 4], s[sub][i0 + 5]); pk.u.w = cvt_pk_bf16(s[sub][i0 + 6], s[sub][i0 + 7]);
#pragma unroll
            for (int dsub = 0; dsub < 2; ++dsub) {
                union { u32x4 u; bf16x8 b; } vf;
                const LAS unsigned char* vrow2 = Vb + (dsub * 32 + ql) * 128 + hh * 8;
                const u32x2 lo = VPRE ? vlo[ks][dsub] : *(const LAS u32x2*)(vrow2 + (((ks * 2) << 4) ^ swz4)), hi = VPRE ? vhi[ks][dsub] : *(const LAS u32x2*)(vrow2 + (((ks * 2 + 1) << 4) ^ swz4));
                vf.u.x = lo.x; vf.u.y = lo.y; vf.u.z = hi.x; vf.u.w = hi.y;
                o[dsub] = __builtin_amdgcn_mfma_f32_32x32x16_bf16(vf.b, pk.b, o[dsub], 0, 0, 0);
            }
        }
    }
}

__device__ __forceinline__ void attn_phase(LAS unsigned char* lds, GAS const bf16_t* Z, GAS const bf16_t* vTs, GAS const bf16_t* vTw, GAS const bf16_t* kc, GAS const bf16_t* vcT, GAS bf16_t* O, int G, int bid) {
    LAS float* imp = (LAS float*)(lds + OFF_IMP);
    LAS float* score = (LAS float*)(lds + OFF_SCORE);
    LAS unsigned char* selb = lds + OFF_SEL;
    LAS unsigned* un = (LAS unsigned*)(lds + OFF_UN);
    LAS unsigned short* tlist = (LAS unsigned short*)(lds + OFF_LIST);
    int cnt = 0;
#define ATT_ISSUE(desc_, k_) do { const int kd_ = (desc_) >> 8, tl_ = (desc_) & 255; \
        GAS const bf16_t* kg_; GAS const bf16_t* vg_; \
        if (kd_ <= 1) { kg_ = kc + ((size_t)bg * 256 + tl_ * 64) * 64 + okc; vg_ = vcT + (size_t)bg * 64 * 256 + tl_ * 64 + ovc; } \
        else if (kd_ <= 3) { kg_ = Z + ((size_t)b * SEQ + tl_ * 64) * NZ + ZC_KSLC + g * 64 + okz; vg_ = vTs + (size_t)bg * 64 * SEQ + tl_ * 64 + ovt; } \
        else { kg_ = Z + ((size_t)b * SEQ + tl_ * 64) * NZ + ZC_KWIN + g * 64 + okz; vg_ = vTw + (size_t)bg * 64 * SEQ + tl_ * 64 + ovt; } \
        LAS unsigned char* sl_ = lds + ((k_) % 3) * SLOT_BYTES + wave * 1024; \
        __builtin_amdgcn_global_load_lds((GAS const unsigned*)kg_, (LAS unsigned*)sl_, 16, 0, 0); \
        __builtin_amdgcn_global_load_lds((GAS const unsigned*)vg_, (LAS unsigned*)(sl_ + 8192), 16, 0, 0); } while (0)
    for (int uidx = bid; uidx < 2048; uidx += G) {
        int tid = threadIdx.x; asm volatile("" : "+v"(tid));
        const int wave = __builtin_amdgcn_readfirstlane(tid >> 6), lane = tid & 63;
        const int hg = wave >> 1, qh = wave & 1, ql = lane & 31, hh = lane >> 5;
        const int qrow = qh * 32 + ql;
        const int kk = uidx >> 8, bb = uidx & 255, r = bb >> 5, bg = (bb & 31) ^ (((kk + 1) >> 1) & 1);
        const int qb = 63 - 8 * kk - ((kk & 1) ? (7 - r) : r);
        const int b = bg >> 1, g = bg & 1;
        const int head = g * 4 + hg;
        const float slope2 = exp2f(-(float)(head + 1)) * LOG2E;
        const int t = qb * 64 + qrow;
        const size_t token = (size_t)b * SEQ + t;
        const int lrow = wave * 8 + (lane >> 3), cfetch = (lane & 7) ^ ((lrow >> 1) & 7);
        const int okc = lrow * 64 + cfetch * 8, ovc = lrow * 256 + cfetch * 8, okz = lrow * NZ + cfetch * 8, ovt = lrow * SEQ + cfetch * 8;
        if (tid < 2) un[tid] = 0u;
        bf16x8 qf[4];
#pragma unroll
        for (int ds = 0; ds < 4; ++ds) qf[ds] = *(GAS const bf16x8*)(Z + token * NZ + ZC_Q + head * 64 + ds * 16 + hh * 8);
        f32x16 o[2];
        LAS float* outst = (LAS float*)(lds + OFF_IMP) + wave * 2048 + lane;
        float prim[8]; float carry = 0.f;
        GAS const bf16_t* gzp = Z + token * NZ + ZC_GNSA + head * 3;
        const float gate0 = __uint_as_float((unsigned)gzp[0] << 16), gate1 = __uint_as_float((unsigned)gzp[1] << 16), gate2 = __uint_as_float((unsigned)gzp[2] << 16);
        float m = NEGV, l = 0.f, inv_l = 0.f;
        const int ntc = (qb >> 4) + 1, nA = 2 * ntc;
#define DESC_A(i_) ((i_) < ntc ? (i_) : (0x100 | ((i_) - ntc)))
        ATT_ISSUE(DESC_A(0), cnt); ATT_ISSUE(DESC_A(1), cnt + 1);
        for (int i = 0; i < nA; ++i) {
            if (i + 1 < nA) asm volatile("s_waitcnt vmcnt(2)" ::: "memory"); else asm volatile("s_waitcnt vmcnt(0)" ::: "memory");
            __builtin_amdgcn_s_barrier(); asm volatile("" ::: "memory");
            if (i + 2 < nA) ATT_ISSUE(DESC_A(i + 2), cnt + 2);
            const LAS unsigned char* Kb = lds + (cnt % 3) * SLOT_BYTES; const LAS unsigned char* Vb = Kb + 8192;
            if (i < ntc) {
                if (1024 * i + 1039 <= 64 * qb) tile_compute<0, true>(Kb, Vb, qf, o, m, l, 0.f, i, t, slope2, true, qb, ql, hh, prim, carry);
                else tile_compute<0, false>(Kb, Vb, qf, o, m, l, 0.f, i, t, slope2, true, qb, ql, hh, prim, carry);
            } else {
                const int tc = i - ntc;
                if (tc == 0) {
                    inv_l = l > 0.f ? 1.0f / l : 0.f;
#pragma unroll
                    for (int e = 0; e < 16; ++e) { o[0][e] = 0.f; o[1][e] = 0.f; }
                }
                if (1024 * tc + 1039 <= 64 * qb) tile_compute<1, true>(Kb, Vb, qf, o, m, l, inv_l, tc, t, slope2, true, qb, ql, hh, prim, carry);
                else tile_compute<1, false>(Kb, Vb, qf, o, m, l, inv_l, tc, t, slope2, true, qb, ql, hh, prim, carry);
#pragma unroll
                for (int k = 0; k < 8; ++k) imp[(hg * 64 + qrow) * IMP_PITCH + tc * 16 + 2 * k + hh] = prim[k];
            }
            ++cnt;
        }
        __syncthreads();
        int tid2 = threadIdx.x; asm volatile("" : "+v"(tid2));
#pragma unroll
        for (int i = 0; i < 8; ++i) {
            const int idx = tid2 + 512 * i, q = idx >> 6, j = idx & 63;
            float sc;
            if (j > qb) sc = NEGV;
            else if (j == 0 || j == qb || j == qb - 1) sc = 1e9f;
            else sc = ((imp[(0 * 64 + q) * IMP_PITCH + j] + imp[(1 * 64 + q) * IMP_PITCH + j]) + imp[(2 * 64 + q) * IMP_PITCH + j]) + imp[(3 * 64 + q) * IMP_PITCH + j];
            score[q * IMP_PITCH + j] = sc;
        }
        __syncthreads();
        {
            const int q = tid2 >> 3, jb = tid2 & 7;
            unsigned long long ownk[8]; int rank[8];
#pragma unroll
            for (int e = 0; e < 8; ++e) { const float sv = score[q * IMP_PITCH + jb * 8 + e]; const unsigned u = sv > 0.f ? __float_as_uint(sv) : 0u; ownk[e] = ((unsigned long long)u << 6) | (unsigned)(63 - (jb * 8 + e)); rank[e] = 0; }
#pragma unroll 4
            for (int j2 = 0; j2 <= qb; ++j2) {
                const float v = score[q * IMP_PITCH + j2];
                const unsigned u = v > 0.f ? __float_as_uint(v) : 0u;
                const unsigned long long kj = ((unsigned long long)u << 6) | (unsigned)(63 - j2);
#pragma unroll
                for (int e = 0; e < 8; ++e) rank[e] += (kj > ownk[e]) ? 1 : 0;
            }
            unsigned byte = 0;
#pragma unroll
            for (int e = 0; e < 8; ++e) byte |= (rank[e] < 16 ? 1u : 0u) << e;
            selb[q * 8 + jb] = (unsigned char)byte;
            atomicOr((unsigned*)(un + (jb >> 2)), byte << (8 * (jb & 3)));
        }
        __syncthreads();
#pragma unroll
        for (int i = 0; i < 16; ++i) { outst[i * 64] = gate0 * o[0][i]; outst[(16 + i) * 64] = gate0 * o[1][i]; }
        const u32x2 selw = *(const LAS u32x2*)(selb + qrow * 8);
        const unsigned long long selmask = ((unsigned long long)selw.y << 32) | selw.x;
        unsigned long long unmask = ((unsigned long long)un[1] << 32) | un[0];
        unmask &= (qb >= 63) ? ~0ull : ((1ull << (qb + 1)) - 1ull);
        const int nslc = (int)__builtin_popcountll(unmask);
        const int j0 = qb >= 8 ? qb - 8 : 0;
        const int nB = nslc + (qb - j0 + 1);
        if (tid2 < 64) { if ((unmask >> tid2) & 1ull) { const int pos = (tid2 >= 63) ? 0 : (int)__builtin_popcountll(unmask >> (tid2 + 1)); tlist[pos] = (unsigned short)(((tid2 == qb) ? 0x300 : 0x200) | tid2); } }
        else if (tid2 < 73) { const int w = tid2 - 64, j = qb - w; if (j >= j0) tlist[nslc + w] = (unsigned short)(((j == qb || j == qb - 8) ? 0x500 : 0x400) | j); }
        __syncthreads();
#define DESC_B(i_) ((int)__builtin_amdgcn_readfirstlane((unsigned)tlist[(i_)]))
        m = NEGV; l = 0.f;
#pragma unroll
        for (int e = 0; e < 16; ++e) { o[0][e] = 0.f; o[1][e] = 0.f; }
        ATT_ISSUE(DESC_B(0), cnt); ATT_ISSUE(DESC_B(1), cnt + 1);
        for (int i = 0; i < nB; ++i) {
            if (i + 1 < nB) asm volatile("s_waitcnt vmcnt(2)" ::: "memory"); else asm volatile("s_waitcnt vmcnt(0)" ::: "memory");
            __builtin_amdgcn_s_barrier(); asm volatile("" ::: "memory");
            if (i + 2 < nB) { const int dn = DESC_B(i + 2); ATT_ISSUE(dn, cnt + 2); }
            const LAS unsigned char* Kb = lds + (cnt % 3) * SLOT_BYTES; const LAS unsigned char* Vb = Kb + 8192;
            const int dsc = DESC_B(i), kind = dsc >> 8, j = dsc & 255;
            if (i == nslc) {
                const float sc = l > 0.f ? gate1 / l : 0.f;
#pragma unroll
                for (int e = 0; e < 16; ++e) { outst[e * 64] += sc * o[0][e]; outst[(16 + e) * 64] += sc * o[1][e]; o[0][e] = 0.f; o[1][e] = 0.f; }
                m = NEGV; l = 0.f;
            }
            if (kind == 2) tile_compute<2, true>(Kb, Vb, qf, o, m, l, 0.f, j, t, slope2, ((selmask >> j) & 1ull) != 0ull, qb, ql, hh, prim, carry);
            else if (kind == 3) tile_compute<2, false>(Kb, Vb, qf, o, m, l, 0.f, j, t, slope2, ((selmask >> j) & 1ull) != 0ull, qb, ql, hh, prim, carry);
            else if (kind == 4) tile_compute<3, true>(Kb, Vb, qf, o, m, l, 0.f, j, t, slope2, true, qb, ql, hh, prim, carry);
            else tile_compute<3, false>(Kb, Vb, qf, o, m, l, 0.f, j, t, slope2, true, qb, ql, hh, prim, carry);
            ++cnt;
        }
        {
            const float sc = l > 0.f ? gate2 / l : 0.f;
#pragma unroll
            for (int e = 0; e < 16; ++e) { o[0][e] = outst[e * 64] + sc * o[0][e]; o[1][e] = outst[(16 + e) * 64] + sc * o[1][e]; }
        }
        GAS bf16_t* op = O + token * 512 + head * 64 + 4 * hh;
#pragma unroll
        for (int dsub = 0; dsub < 2; ++dsub)
#pragma unroll
            for (int i4 = 0; i4 < 4; ++i4) {
                u32x2 w; w.x = cvt_pk_bf16(o[dsub][4 * i4 + 0], o[dsub][4 * i4 + 1]); w.y = cvt_pk_bf16(o[dsub][4 * i4 + 2], o[dsub][4 * i4 + 3]);
                *(GAS u32x2*)(op + dsub * 32 + 8 * i4) = w;
            }
        __syncthreads();
    }
#undef ATT_ISSUE
#undef DESC_A
#undef DESC_B
}
}

struct Args { const float* in[28]; float* out; unsigned char* ws; };

constexpr int PTAB_OFF = 143360;
__device__ __forceinline__ GAS const float* karg(const LAS unsigned char* lds, int slot) {
    const LAS unsigned* pt = (const LAS unsigned*)(lds + PTAB_OFF) + 2 * slot;
    const unsigned lo = __builtin_amdgcn_readfirstlane(pt[0]), hi = __builtin_amdgcn_readfirstlane(pt[1]);
    return (GAS const float*)(((unsigned long long)hi << 32) | lo);
}
#define INP(i) karg(lds, i)
#define WSB(off) ((GAS bf16_t*)((GAS unsigned char*)karg(lds, 29) + (off)))
#define WSF(off) ((GAS float*)((GAS unsigned char*)karg(lds, 29) + (off)))
#define XOUT ((GAS float*)karg(lds, 28))

__global__ void __launch_bounds__(512, 2) mega_fwd(Args a) {
    extern __shared__ __attribute__((aligned(16))) unsigned char lds_raw[];
    LAS unsigned char* lds = (LAS unsigned char*)lds_raw;
    cg::grid_group grid = cg::this_grid();
    const int tid = threadIdx.x, lane = tid & 63, wave = __builtin_amdgcn_readfirstlane(tid >> 6);
    const int G = gridDim.x, bid = blockIdx.x;
    const int gw = bid * 8 + wave, NGW = G * 8;
    if (tid == 0) {
        LAS unsigned long long* pt = (LAS unsigned long long*)(lds + PTAB_OFF);
#pragma unroll
        for (int i = 0; i < 28; ++i) pt[i] = (unsigned long long)a.in[i];
        pt[28] = (unsigned long long)a.out; pt[29] = (unsigned long long)a.ws;
    }
    __syncthreads();

    {
        LAS float* cact = (LAS float*)lds;
        GAS const float* c = INP(1);
        for (int i = tid; i < NBATCH * D; i += 512) { const int bb = i >> 10, k = i & 1023; cact[k * 16 + bb] = siluf_(c[i]); }
        __syncthreads();
        for (int item = bid; item < NADA / 64; item += G) {
            const int j = item * 64 + lane; GAS const float* w = INP(4) + j + (size_t)(wave * 128) * NADA;
            float acc[16];
#pragma unroll
            for (int bb = 0; bb < 16; ++bb) acc[bb] = 0.f;
#pragma unroll 16
            for (int k = 0; k < 128; ++k) {
                const float wv = w[(size_t)k * NADA];
                const LAS f32x4* cp = (const LAS f32x4*)(cact + (wave * 128 + k) * 16);
                const f32x4 c0 = cp[0], c1 = cp[1], c2 = cp[2], c3 = cp[3];
                acc[0] += c0.x * wv; acc[1] += c0.y * wv; acc[2] += c0.z * wv; acc[3] += c0.w * wv;
                acc[4] += c1.x * wv; acc[5] += c1.y * wv; acc[6] += c1.z * wv; acc[7] += c1.w * wv;
                acc[8] += c2.x * wv; acc[9] += c2.y * wv; acc[10] += c2.z * wv; acc[11] += c2.w * wv;
                acc[12] += c3.x * wv; acc[13] += c3.y * wv; acc[14] += c3.z * wv; acc[15] += c3.w * wv;
            }
            LAS float* part = (LAS float*)(lds + 65536);
#pragma unroll
            for (int bb = 0; bb < 16; ++bb) part[wave * 1024 + bb * 64 + lane] = acc[bb];
            __syncthreads();
#pragma unroll
            for (int h = 0; h < 2; ++h) {
                const int bsel = (tid >> 6) + 8 * h, col = tid & 63;
                float sum = 0.f;
#pragma unroll
                for (int w8 = 0; w8 < 8; ++w8) sum += part[w8 * 1024 + bsel * 64 + col];
                WSF(WS_ADA)[(size_t)bsel * NADA + item * 64 + col] = sum + INP(5)[item * 64 + col];
            }
            __syncthreads();
        }
        LAS float* scr = (LAS float*)(lds + 65536 + wave * 8448);
        constexpr int I_WA = 1024;
        constexpr int I_IN = 16 * (2 * DFF / 32), I_OUT = (DFF / 64) * 32, I_MIX = 16 * (NZ / 32), I_WB = 8 * 32, I_MO = 16 * 32, I_C1 = 32 * 8, I_C2 = 4 * 8;
        constexpr int NITEMS = I_WA + 2 * I_IN + 2 * I_OUT + I_MIX + I_WB + I_MO + 2 * I_C1 + 2 * I_C2;
        for (int it = gw; it < NITEMS; it += NGW) {
            int r = it;
            if (r < I_WA) {
                const int gq = r >> 8, rem = r & 255, c0 = (rem >> 4) * 8, n0 = (rem & 15) * 64;
                GAS const float* pw = INP(11) + ((size_t)gq * 128 + c0) * 128; GAS const float* psc = INP(12) + gq * 128; GAS const float* wba = INP(19) + (size_t)gq * 128 * D + n0 + lane;
                float acc[8];
#pragma unroll
                for (int ci = 0; ci < 8; ++ci) acc[ci] = 0.f;
#pragma unroll 16
                for (int d = 0; d < 128; ++d) {
                    const float wv = wba[(size_t)d * D] * psc[d];
#pragma unroll
                    for (int ci = 0; ci < 8; ++ci) acc[ci] += pw[ci * 128 + d] * wv;
                }
                u32x4 o; o.x = cvt_pk_bf16(acc[0], acc[1]); o.y = cvt_pk_bf16(acc[2], acc[3]); o.z = cvt_pk_bf16(acc[4], acc[5]); o.w = cvt_pk_bf16(acc[6], acc[7]);
                *(GAS u32x4*)(WSB(WS_WA) + (size_t)(n0 + lane) * 512 + gq * 128 + c0) = o;
                continue;
            }
            r -= I_WA;
            if (r < I_IN) { tr_item(INP(6), 2 * DFF, WSB(WS_W1IN), D, 1, scr, r, 2 * DFF / 32, lane); continue; } r -= I_IN;
            if (r < I_IN) { tr_item(INP(24), 2 * DFF, WSB(WS_W2IN), D, 1, scr, r, 2 * DFF / 32, lane); continue; } r -= I_IN;
            if (r < I_OUT) { tr_item(INP(7), D, WSB(WS_W1OUT), DFF, 0, scr, r, 32, lane); continue; } r -= I_OUT;
            if (r < I_OUT) { tr_item(INP(25), D, WSB(WS_W2OUT), DFF, 0, scr, r, 32, lane); continue; } r -= I_OUT;
            if (r < I_MIX) { tr_item(INP(10), 3864, WSB(WS_WMIX), D, 2, scr, r, NZ / 32, lane); continue; } r -= I_MIX;
            if (r < I_WB) { tr_item(INP(20), D, WSB(WS_WB), 512, 0, scr, r, 32, lane); continue; } r -= I_WB;
            if (r < I_MO) { tr_item(INP(21), D, WSB(WS_WMO), D, 0, scr, r, 32, lane); continue; } r -= I_MO;
            if (r < I_C1) { tr_item(INP(14), 256, WSB(WS_CKW1), 2048, 0, scr, r, 8, lane); continue; } r -= I_C1;
            if (r < I_C1) { tr_item(INP(17), 256, WSB(WS_CVW1), 2048, 0, scr, r, 8, lane); continue; } r -= I_C1;
            if (r < I_C2) { tr_item(INP(15), 64, WSB(WS_CKW2), 256, 3, scr, r, 8, lane); continue; } r -= I_C2;
            tr_item(INP(18), 64, WSB(WS_CVW2), 256, 3, scr, r, 8, lane);
        }
    }
    grid.sync();
    ln_rows<false, true, false, false>(INP(0), WSB(WS_H), XOUT, WSB(WS_H), INP(2), INP(3), WSF(WS_ADA), 0, INP(2), INP(3), gw, NGW, lane);
    grid.sync();
    pg8::StaticOrder S;
#ifndef REP_G1
#define REP_G1 1
#endif
#pragma unroll 1
    for (int rep = 0; rep < REP_G1; ++rep)
    { pg8::Gemm g{WSB(WS_H), WSB(WS_W1IN), M, 2 * DFF, D, D, D}; S.init(M, 2 * DFF, G, bid); pg8::EpiSwiglu E{WSB(WS_ACT)}; pg8::gemm_phase(lds, g, S, E); }
    grid.sync();
    { pg8::Gemm g{WSB(WS_ACT), WSB(WS_W1OUT), M, D, DFF, DFF, DFF}; S.init(M, D, G, bid); pg8::EpiY E{WSB(WS_H), WSF(WS_ADA) + 2 * D, 0.5f}; pg8::gemm_phase(lds, g, S, E); }
    grid.sync();
    ln_rows<true, true, true, true>(INP(0), WSB(WS_H), XOUT, WSB(WS_H), INP(8), INP(9), WSF(WS_ADA), 1, INP(2), INP(3), gw, NGW, lane);
    grid.sync();
#if MIXER_MODE >= 1
    { pg8::Gemm g{WSB(WS_H), WSB(WS_WMIX), M, NZ, D, D, D}; S.init(M, NZ, G, bid); pg8::EpiZ E{WSB(WS_ACT)}; pg8::gemm_phase(lds, g, S, E); }
    grid.sync();
    {
        constexpr int I_DELTA = M / 32, I_VT = 2 * 32 * 64, I_BLK = 2 * 8192 / 4;
        LAS unsigned char* tsc = lds + wave * 9216;
        GAS const bf16_t* Zp = WSB(WS_ACT);
#define UNPK8(v_, f_) do { f_[0] = bf_lo(v_.x); f_[1] = bf_hi(v_.x); f_[2] = bf_lo(v_.y); f_[3] = bf_hi(v_.y); f_[4] = bf_lo(v_.z); f_[5] = bf_hi(v_.z); f_[6] = bf_lo(v_.w); f_[7] = bf_hi(v_.w); } while (0)
        for (int it = gw; it < I_DELTA + I_VT + I_BLK; it += NGW) {
            int r = it;
            if (r < I_DELTA) {
                const int tok0 = r * 32, tpos0 = tok0 & (SEQ - 1), w = 2 << (lane >> 4);
                GAS const bf16_t* zp = Zp + (size_t)tok0 * NZ + lane * 8;
                GAS bf16_t* dp = WSB(WS_DELTA) + (size_t)tok0 * 512 + lane * 8;
                float sum[8];
#pragma unroll
                for (int e = 0; e < 8; ++e) sum[e] = 0.f;
#pragma unroll
                for (int i = 1; i < 16; ++i) {
                    if (i < w && tpos0 - i >= 0) {
                        const u32x4 v = *(GAS const u32x4*)(zp - (long)i * NZ); float f[8]; UNPK8(v, f);
#pragma unroll
                        for (int e = 0; e < 8; ++e) sum[e] += f[e];
                    }
                }
#pragma unroll 1
                for (int s4 = 0; s4 < 32; s4 += 4) {
                    u32x4 cur[4], old[4];
#pragma unroll
                    for (int q = 0; q < 4; ++q) {
                        cur[q] = *(GAS const u32x4*)(zp + (long)(s4 + q) * NZ);
                        const int back = s4 + q - w + 1;
                        old[q] = (tpos0 + back >= 0) ? *(GAS const u32x4*)(zp + (long)back * NZ) : (u32x4){0u, 0u, 0u, 0u};
                    }
#pragma unroll
                    for (int q = 0; q < 4; ++q) {
                        float f[8], fo[8]; UNPK8(cur[q], f); UNPK8(old[q], fo);
                        const int tpos = tpos0 + s4 + q; const int cnt = (tpos + 1) < w ? (tpos + 1) : w;
                        const float ic = 1.0f / (float)cnt;
#pragma unroll
                        for (int e = 0; e < 8; ++e) sum[e] += f[e];
                        u32x4 o; o.x = cvt_pk_bf16(sum[0] * ic - f[0], sum[1] * ic - f[1]); o.y = cvt_pk_bf16(sum[2] * ic - f[2], sum[3] * ic - f[3]);
                        o.z = cvt_pk_bf16(sum[4] * ic - f[4], sum[5] * ic - f[5]); o.w = cvt_pk_bf16(sum[6] * ic - f[6], sum[7] * ic - f[7]);
                        *(GAS u32x4*)(dp + (size_t)(s4 + q) * 512) = o;
#pragma unroll
                        for (int e = 0; e < 8; ++e) sum[e] -= fo[e];
                    }
                }
                continue;
            }
            r -= I_DELTA;
            if (r < I_VT) {
                const int which = r >> 11, rem = r & 2047, bg = rem >> 6, tile = rem & 63, b = bg >> 1, g = bg & 1;
                GAS const bf16_t* src = Zp + ((size_t)b * SEQ + tile * 64) * NZ + (which ? ZC_VWIN : ZC_VSLC) + g * 64;
                GAS bf16_t* dst = (which ? WSB(WS_VTW) : WSB(WS_VTS)) + (size_t)bg * 64 * SEQ + tile * 64;
                u32x4 vv[8];
#pragma unroll
                for (int i = 0; i < 8; ++i) vv[i] = *(GAS const u32x4*)(src + (size_t)(i * 8 + (lane >> 3)) * NZ + (lane & 7) * 8);
#pragma unroll
                for (int i = 0; i < 8; ++i) {
                    const int row = i * 8 + (lane >> 3), ch = lane & 7; const u32x4 v = vv[i];
                    LAS bf16_t* tp = (LAS bf16_t*)tsc + (ch * 8) * 72 + row;
                    tp[0 * 72] = (bf16_t)(v.x & 0xffffu); tp[1 * 72] = (bf16_t)(v.x >> 16); tp[2 * 72] = (bf16_t)(v.y & 0xffffu); tp[3 * 72] = (bf16_t)(v.y >> 16);
                    tp[4 * 72] = (bf16_t)(v.z & 0xffffu); tp[5 * 72] = (bf16_t)(v.z >> 16); tp[6 * 72] = (bf16_t)(v.w & 0xffffu); tp[7 * 72] = (bf16_t)(v.w >> 16);
                }
                LDS_WAIT(); asm volatile("" ::: "memory");
#pragma unroll
                for (int i = 0; i < 8; ++i) {
                    const int d = i * 8 + (lane >> 3), ch = lane & 7;
                    const u32x4 v = *(const LAS u32x4*)(tsc + d * 144 + ch * 16);
                    *(GAS u32x4*)(dst + (size_t)d * SEQ + ch * 8) = v;
                }
                LDS_WAIT(); asm volatile("" ::: "memory");
                continue;
            }
            r -= I_VT;
            {
                const int which = r >> 11, rowbase = (r & 2047) * 4, bg = rowbase >> 8, b = bg >> 1, g = bg & 1;
                GAS const float* pos = which ? INP(16) : INP(13);
                GAS bf16_t* dst = (which ? WSB(WS_VBLK) : WSB(WS_KBLK)) + (size_t)rowbase * 2048;
                GAS const bf16_t* src = Zp + (size_t)b * SEQ * NZ + (which ? ZC_VCMP : ZC_KCMP) + g * 64;
                u32x4 vv[4][4];
#pragma unroll
                for (int rr = 0; rr < 4; ++rr) {
                    const int n = (rowbase + rr) & 255;
#pragma unroll
                    for (int i = 0; i < 4; ++i) {
                        const int ch = lane + 64 * i, pp = ch >> 3, dc = ch & 7;
                        vv[rr][i] = (n < 255) ? *(GAS const u32x4*)(src + (size_t)(16 * n + pp) * NZ + dc * 8) : (u32x4){0u, 0u, 0u, 0u};
                    }
                }
#pragma unroll
                for (int i = 0; i < 4; ++i) {
                    const int ch = lane + 64 * i, pp = ch >> 3, dc = ch & 7;
                    const f32x4 p0 = *(GAS const f32x4*)(pos + pp * 64 + dc * 8), p1 = *(GAS const f32x4*)(pos + pp * 64 + dc * 8 + 4);
#pragma unroll
                    for (int rr = 0; rr < 4; ++rr) {
                        const int n = (rowbase + rr) & 255; const u32x4 v = vv[rr][i];
                        u32x4 o = (u32x4){0u, 0u, 0u, 0u};
                        if (n < 255) {
                            o.x = cvt_pk_bf16(bf_lo(v.x) + p0.x, bf_hi(v.x) + p0.y); o.y = cvt_pk_bf16(bf_lo(v.y) + p0.z, bf_hi(v.y) + p0.w);
                            o.z = cvt_pk_bf16(bf_lo(v.z) + p1.x, bf_hi(v.z) + p1.y); o.w = cvt_pk_bf16(bf_lo(v.w) + p1.z, bf_hi(v.w) + p1.w);
                        }
                        *(GAS u32x4*)(dst + (size_t)rr * 2048 + ch * 8) = o;
                    }
                }
            }
        }
#undef UNPK8
    }
    grid.sync();
#if MIXER_MODE >= 2
#pragma unroll 1
    for (int s = 0; s < 2; ++s) {
        pg8::Gemm g{s ? WSB(WS_VBLK) : WSB(WS_KBLK), s ? WSB(WS_CVW1) : WSB(WS_CKW1), 8192, 256, 2048, 2048, 2048}; S.init(8192, 256, G, s ? (bid + G - 32) % G : bid);
        pg8::EpiCmp1 E{s ? WSB(WS_HIDV) : WSB(WS_HIDK)}; pg8::gemm_phase(lds, g, S, E);
    }
    __syncthreads();
#pragma unroll 1
    for (int s = 0; s < 2; ++s) {
        pg8::Gemm g{s ? WSB(WS_HIDV) : WSB(WS_HIDK), s ? WSB(WS_CVW2) : WSB(WS_CKW2), 8192, 256, 256, 256, 256}; S.init(8192, 256, G, s ? (bid + G - 32) % G : bid);
        pg8::EpiCmp2 E{s ? WSB(WS_VCT) : WSB(WS_KC), s}; pg8::gemm_phase(lds, g, S, E);
    }
    grid.sync();
#ifndef REP_ATT
#define REP_ATT 1
#endif
#pragma unroll 1
    for (int rep = 0; rep < REP_ATT; ++rep)
        att::attn_phase(lds, WSB(WS_ACT), WSB(WS_VTS), WSB(WS_VTW), WSB(WS_KC), WSB(WS_VCT), WSB(WS_O), G, bid);
    grid.sync();
#endif
    { pg8::Gemm g{WSB(WS_DELTA), WSB(WS_WA), M, D, 512, 512, 512}; S.init(M, D, G, bid); pg8::EpiGate E{WSB(WS_ACT), WSB(WS_H), ZC_GA, 0}; pg8::gemm_phase(lds, g, S, E); }
#if MIXER_MODE >= 2
    { pg8::Gemm g{WSB(WS_O), WSB(WS_WB), M, D, 512, 512, 512}; S.init(M, D, G, bid); pg8::EpiGate E{WSB(WS_ACT), WSB(WS_H), ZC_GB, 1}; pg8::gemm_phase(lds, g, S, E); }
#endif
    grid.sync();
    { pg8::Gemm g{WSB(WS_H), WSB(WS_WMO), M, D, D, D, D}; S.init(M, D, G, bid); pg8::EpiY E{WSB(WS_DELTA), WSF(WS_ADA) + 5 * D, 1.0f}; pg8::gemm_phase(lds, g, S, E); }
    grid.sync();
#else
    for (size_t i = (size_t)bid * 512 + tid; i < (size_t)M * D / 4; i += (size_t)G * 512) { f32x4 v = ((GAS f32x4*)XOUT)[i]; ((GAS f32x4*)XOUT)[i] = v * ALPHA; }
    grid.sync();
#endif
    ln_rows<true, true, true, false>(XOUT, WSB(WS_DELTA), XOUT, WSB(WS_H), INP(22), INP(23), WSF(WS_ADA), 2, INP(2), INP(3), gw, NGW, lane);
    grid.sync();
    { pg8::Gemm g{WSB(WS_H), WSB(WS_W2IN), M, 2 * DFF, D, D, D}; S.init(M, 2 * DFF, G, bid); pg8::EpiSwiglu E{WSB(WS_ACT)}; pg8::gemm_phase(lds, g, S, E); }
    grid.sync();
    { pg8::Gemm g{WSB(WS_ACT), WSB(WS_W2OUT), M, D, DFF, DFF, DFF}; S.init(M, D, G, bid); pg8::EpiY E{WSB(WS_H), WSF(WS_ADA) + 8 * D, 0.5f}; pg8::gemm_phase(lds, g, S, E); }
    grid.sync();
    ln_rows<true, false, true, false>(XOUT, WSB(WS_H), XOUT, WSB(WS_H), INP(26), INP(27), WSF(WS_ADA), 0, INP(2), INP(3), gw, NGW, lane);
}

extern "C" void kernel_launch(void* const* d_in, const int* in_sizes, int n_in, void* d_out, int out_size, void* d_ws, size_t ws_size, hipStream_t stream) {
    static int grid = 0;
    if (grid == 0) {
        if (n_in != 28 || out_size != M * D || ws_size < WS_END) { fprintf(stderr, "kernel_launch: unexpected shapes (n_in %d out %d ws %zu)\n", n_in, out_size, ws_size); grid = -1; return; }
        int dev = 0, cus = 0, per_cu = 0;
        hipGetDevice(&dev);
        hipDeviceGetAttribute(&cus, hipDeviceAttributeMultiprocessorCount, dev);
        if (hipFuncSetAttribute((const void*)mega_fwd, hipFuncAttributeMaxDynamicSharedMemorySize, LDS_BYTES) != hipSuccess) { fprintf(stderr, "kernel_launch: hipFuncSetAttribute failed\n"); grid = -1; return; }
        if (hipOccupancyMaxActiveBlocksPerMultiprocessor(&per_cu, (const void*)mega_fwd, 512, LDS_BYTES) != hipSuccess || per_cu < 1) { fprintf(stderr, "kernel_launch: occupancy query says %d\n", per_cu); per_cu = 1; }
        (void)hipGetLastError();
        grid = cus * per_cu;
    }
    if (grid < 0) return;
    Args a{};
    for (int i = 0; i < 28; ++i) a.in[i] = (const float*)d_in[i];
    a.out = (float*)d_out; a.ws = (unsigned char*)d_ws;
    void* args[] = {&a};
    hipError_t e = hipLaunchCooperativeKernel((const void*)mega_fwd, dim3(grid), dim3(512), args, LDS_BYTES, stream);
    if (e != hipSuccess) fprintf(stderr, "cooperative launch failed: %s (grid %d)\n", hipGetErrorString(e), grid);
}
```

```cpp
#include <hip/hip_runtime.h>
#include <hip/hip_cooperative_groups.h>
#include <cstdio>
#include <cstdint>
namespace cg = cooperative_groups;

#define LAS __attribute__((address_space(3)))
#define GAS __attribute__((address_space(1)))
typedef unsigned short bf16_t;
typedef short bf16x8 __attribute__((ext_vector_type(8)));
typedef float f32x4 __attribute__((ext_vector_type(4)));
typedef float f32x16 __attribute__((ext_vector_type(16)));
typedef unsigned u32x4 __attribute__((ext_vector_type(4)));
typedef unsigned u32x2 __attribute__((ext_vector_type(2)));

#ifndef MIXER_MODE
#define MIXER_MODE 2
#endif

constexpr int D = 1024, NBATCH = 16, SEQ = 4096, M = NBATCH * SEQ, DFF = 2816, NZ = 4096, NADA = 9 * D;
constexpr float ALPHA = 1.189207115002721f;
constexpr float LN_EPS = 1e-5f;
constexpr float LOG2E = 1.4426950408889634f;
constexpr int ZC_Q = 512, ZC_KCMP = 1024, ZC_VCMP = 1152, ZC_KSLC = 1280, ZC_VSLC = 1408, ZC_KWIN = 1536, ZC_VWIN = 1664, ZC_GNSA = 1792, ZC_GA = 2048, ZC_GB = 3072;

constexpr size_t MiB = 1u << 20;
constexpr size_t WS_ADA = 1 * MiB;
constexpr size_t WS_W1IN = 2 * MiB;
constexpr size_t WS_W1OUT = 13 * MiB;
constexpr size_t WS_W2IN = 19 * MiB;
constexpr size_t WS_W2OUT = 30 * MiB;
constexpr size_t WS_WMIX = 36 * MiB;
constexpr size_t WS_WA = 44 * MiB;
constexpr size_t WS_WB = 45 * MiB;
constexpr size_t WS_WMO = 46 * MiB;
constexpr size_t WS_CKW1 = 48 * MiB;
constexpr size_t WS_CVW1 = 49 * MiB;
constexpr size_t WS_CKW2 = 50 * MiB;
constexpr size_t WS_CVW2 = 50 * MiB + 512 * 1024;
constexpr size_t WS_KC = 51 * MiB;
constexpr size_t WS_VCT = 52 * MiB;
constexpr size_t WS_HIDK = 53 * MiB;
constexpr size_t WS_HIDV = 57 * MiB;
constexpr size_t WS_VTS = 64 * MiB;
constexpr size_t WS_VTW = 80 * MiB;
constexpr size_t WS_H = 96 * MiB;
constexpr size_t WS_DELTA = 224 * MiB;
constexpr size_t WS_O = 288 * MiB;
constexpr size_t WS_ACT = 352 * MiB;
constexpr size_t WS_KBLK = 864 * MiB;
constexpr size_t WS_VBLK = 896 * MiB;
constexpr size_t WS_END = 928 * MiB;

constexpr int LDS_BYTES = 147456;

__device__ __forceinline__ unsigned cvt_pk_bf16(float lo, float hi) { unsigned r; asm("v_cvt_pk_bf16_f32 %0, %1, %2" : "=v"(r) : "v"(lo), "v"(hi)); return r; }
__device__ __forceinline__ float bf_lo(unsigned u) { return __uint_as_float(u << 16); }
__device__ __forceinline__ float bf_hi(unsigned u) { return __uint_as_float(u & 0xffff0000u); }
__device__ __forceinline__ float fast_rcp(float x) { return __builtin_amdgcn_rcpf(x); }
__device__ __forceinline__ float fast_exp2(float x) { return __builtin_amdgcn_exp2f(x); }
__device__ __forceinline__ float sigmoidf_(float x) { return fast_rcp(1.0f + fast_exp2(-x * LOG2E)); }
__device__ __forceinline__ float siluf_(float x) { return x * sigmoidf_(x); }
__device__ __forceinline__ float gelu_tanh(float x) { const float u = 0.7978845608028654f * (x + 0.044715f * x * x * x); const float e = fast_exp2(2.0f * LOG2E * u); const float th = 1.0f - 2.0f * fast_rcp(e + 1.0f); return 0.5f * x * (1.0f + th); }
#define LDS_WAIT() asm volatile("s_waitcnt lgkmcnt(0)" ::: "memory")

namespace pg8 {
constexpr int BM = 256, BK = 64, HALF = 128, HTB = HALF * BK * 2, STAGE_BYTES = 8 * HTB, NXCD = 8, WGM = 8;
__host__ __device__ __forceinline__ int lds_byte(int r, int c) { const int st = (r >> 4) * 2 + (c >> 5), rr = r & 15, cc = c & 31, ob = rr * 64 + cc * 2; return st * 1024 + (ob ^ (((ob >> 9) & 1) << 5)); }
__host__ __device__ __forceinline__ void stage_rc(int b, int& R, int& C) { const int st = b / 1024, sb = b % 1024, swz = sb ^ (((sb >> 9) & 1) << 5); R = (st >> 1) * 16 + swz / 64; C = (st & 1) * 32 + (swz % 64) / 2; }
__host__ __device__ __forceinline__ int perm32(int rho) { const int n = rho >> 4, i = rho & 15; return 8 * (i >> 2) + 4 * n + (i & 3); }

struct Unit { int pm, pn; };
struct Gemm { GAS const bf16_t* A; GAS const bf16_t* Bt; int M, N, K, lda, ldb; };

struct StaticOrder {
    int nM, nN, nwg, G, c;
    __device__ void init(int M_, int N_, int G_, int c_) { nM = M_ / BM; nN = N_ / BM; nwg = nM * nN; G = G_; c = c_; }
    __device__ bool next(int i, Unit& u) const {
        const long L = (long)i * G + c; if (L >= nwg) return false;
        int wgid = (int)L; { const int q = nwg / NXCD, r = nwg % NXCD, xcd = wgid % NXCD, off = wgid / NXCD; wgid = (xcd < r ? xcd * (q + 1) : r * (q + 1) + (xcd - r) * q) + off; }
        const int nig = WGM * nN, gid = wgid / nig, fm = gid * WGM, gsz = (nM - fm) < WGM ? (nM - fm) : WGM;
        u.pm = fm + ((wgid % nig) % gsz); u.pn = (wgid % nig) / gsz; return true;
    }
};

template <class Epi>
__device__ __forceinline__ void gemm_phase(LAS unsigned char* lds, const Gemm g, const StaticOrder& S, const Epi& E) {
    int tid_ = threadIdx.x; asm volatile("" : "+v"(tid_));
    const int tid = tid_, wid = __builtin_amdgcn_readfirstlane(tid >> 6), lane = tid & 63, wr = wid >> 2, wc = wid & 3, fr = lane & 15, fq = lane >> 4;
    const int K = g.K, nt = K / BK;
    unsigned voffA[2], voffB[2];
#pragma unroll
    for (int i = 0; i < 2; ++i) { int R, C; stage_rc(tid * 16 + i * 8192, R, C); const int Rb = Epi::PERM ? ((R & ~31) + perm32(R & 31)) : R;
        voffA[i] = (unsigned)(R * g.lda + C) * 2u; voffB[i] = (unsigned)(Rb * g.ldb + C) * 2u; }
    const size_t kstep = (size_t)(BK * 2);
    const size_t hstepA = (size_t)HALF * g.lda * 2, hstepB = (size_t)HALF * g.ldb * 2;
    const size_t tstepA = 2 * hstepA, tstepB = 2 * hstepB;
    const unsigned ldsw = (unsigned)wid * 1024u;
    const int aoff = lds_byte(wr * 64 + fr, fq * 8), boff = lds_byte(wc * 32 + fr, fq * 8);
#define PG8_SA(b, h) (((b) * 2 + (h)) * HTB)
#define PG8_SB(b, h) ((4 + (b) * 2 + (h)) * HTB)
#define PG8_STAGE(bufoff, gbase, voff) do { _Pragma("unroll") for (int _i = 0; _i < 2; ++_i) \
        __builtin_amdgcn_global_load_lds((GAS const unsigned*)((gbase) + (voff)[_i]), (LAS unsigned*)(lds + (bufoff) + ldsw + _i * 8192), 16, 0, 0); } while (0)
#define PG8_LDA(dst, b, h) do { _Pragma("unroll") for (int m = 0; m < 4; ++m) _Pragma("unroll") for (int k = 0; k < 2; ++k) dst[m][k] = *(const LAS bf16x8*)(lds + PG8_SA(b, h) + aoff + m * 2048 + k * 1024); } while (0)
#define PG8_LDB(dst, b, h) do { _Pragma("unroll") for (int n = 0; n < 2; ++n) _Pragma("unroll") for (int k = 0; k < 2; ++k) dst[n][k] = *(const LAS bf16x8*)(lds + PG8_SB(b, h) + boff + n * 2048 + k * 1024); } while (0)
#define PG8_MMA(ai, bj, At, Bt) do { __builtin_amdgcn_s_setprio(1); _Pragma("unroll") for (int m = 0; m < 4; ++m) _Pragma("unroll") for (int n = 0; n < 2; ++n) _Pragma("unroll") for (int k = 0; k < 2; ++k) \
        acc[ai][bj][m][n] = __builtin_amdgcn_mfma_f32_16x16x32_bf16(Bt[n][k], At[m][k], acc[ai][bj][m][n], 0, 0, 0); __builtin_amdgcn_s_setprio(0); } while (0)
#define PG8_WAIT_V(n) asm volatile("s_waitcnt vmcnt(" #n ")" ::: "memory")
#define PG8_WAIT_L(n) asm volatile("s_waitcnt lgkmcnt(" #n ")" ::: "memory")
#define PG8_BAR __builtin_amdgcn_s_barrier()
#define PG8_SCHED __builtin_amdgcn_sched_barrier(0)
    Unit cur, nxt; int ui = 0;
    if (!S.next(0, cur)) return;
    f32x4 acc[2][2][4][2];
#pragma unroll
    for (int a = 0; a < 2; ++a)
#pragma unroll
        for (int b = 0; b < 2; ++b)
#pragma unroll
            for (int m = 0; m < 4; ++m)
#pragma unroll
                for (int n = 0; n < 2; ++n) acc[a][b][m][n] = (f32x4){0.f, 0.f, 0.f, 0.f};
    bf16x8 At[4][2], B0[2][2], B1[2][2];
    GAS const char* cA = (GAS const char*)g.A + (size_t)cur.pm * tstepA; GAS const char* cB = (GAS const char*)g.Bt + (size_t)cur.pn * tstepB;
    PG8_STAGE(PG8_SB(0, 0), cB, voffB); PG8_STAGE(PG8_SB(0, 1), cB + hstepB, voffB); PG8_STAGE(PG8_SA(0, 0), cA, voffA); PG8_STAGE(PG8_SA(0, 1), cA + hstepA, voffA);
    if (wr == 1) PG8_BAR;
    PG8_WAIT_V(2); PG8_BAR;
    PG8_STAGE(PG8_SB(1, 0), cB + kstep, voffB); PG8_STAGE(PG8_SA(1, 0), cA + kstep, voffA); PG8_STAGE(PG8_SB(1, 1), cB + hstepB + kstep, voffB);
    PG8_WAIT_V(6); PG8_BAR;
    for (;;) {
        const bool has_next = S.next(ui + 1, nxt);
        GAS const char* nA = has_next ? (GAS const char*)g.A + (size_t)nxt.pm * tstepA : cA; GAS const char* nB = has_next ? (GAS const char*)g.Bt + (size_t)nxt.pn * tstepB : cB;
        for (int t = 0; t < nt; t += 2) {
            const bool last = (t == nt - 2);
            GAS const char* a1 = cA + (size_t)(t + 1) * kstep;
            GAS const char* a2 = last ? nA : cA + (size_t)(t + 2) * kstep; GAS const char* b2 = last ? nB : cB + (size_t)(t + 2) * kstep;
            GAS const char* a3 = a2 + kstep; GAS const char* b3 = b2 + kstep;
            PG8_LDB(B0, 0, 0); PG8_LDB(B1, 0, 1); PG8_SCHED; PG8_LDA(At, 0, 0); PG8_STAGE(PG8_SA(1, 1), a1 + hstepA, voffA);
            PG8_WAIT_V(8); PG8_WAIT_L(0); PG8_BAR; PG8_MMA(0, 0, At, B0); PG8_MMA(0, 1, At, B1); PG8_BAR; PG8_SCHED;
            PG8_LDA(At, 0, 1); PG8_STAGE(PG8_SB(0, 0), b2, voffB); PG8_STAGE(PG8_SB(0, 1), b2 + hstepB, voffB); PG8_STAGE(PG8_SA(0, 0), a2, voffA);
            PG8_WAIT_V(8); PG8_WAIT_L(0); PG8_BAR; PG8_MMA(1, 0, At, B0); PG8_MMA(1, 1, At, B1); PG8_BAR; PG8_SCHED;
            PG8_LDB(B0, 1, 0); PG8_LDB(B1, 1, 1); PG8_SCHED; PG8_LDA(At, 1, 0); PG8_STAGE(PG8_SA(0, 1), a2 + hstepA, voffA);
            PG8_WAIT_V(8); PG8_WAIT_L(0); PG8_BAR; PG8_MMA(0, 0, At, B0); PG8_MMA(0, 1, At, B1); PG8_BAR; PG8_SCHED;
            PG8_LDA(At, 1, 1); PG8_STAGE(PG8_SB(1, 0), b3, voffB); PG8_STAGE(PG8_SB(1, 1), b3 + hstepB, voffB); PG8_STAGE(PG8_SA(1, 0), a3, voffA);
            PG8_WAIT_V(8); PG8_WAIT_L(0); PG8_BAR; PG8_MMA(1, 0, At, B0); PG8_MMA(1, 1, At, B1); PG8_BAR; PG8_SCHED;
        }
        if (wr == 0) PG8_BAR;
        E(acc, cur, wr, wc, fr, fq);
        if (!has_next) break;
#pragma unroll
        for (int a = 0; a < 2; ++a)
#pragma unroll
            for (int b = 0; b < 2; ++b)
#pragma unroll
                for (int m = 0; m < 4; ++m)
#pragma unroll
                    for (int n = 0; n < 2; ++n) acc[a][b][m][n] = (f32x4){0.f, 0.f, 0.f, 0.f};
        cur = nxt; cA = nA; cB = nB; ++ui;
        if (wr == 1) PG8_BAR;
    }
    PG8_WAIT_V(0);
    PG8_BAR;
#undef PG8_SA
#undef PG8_SB
#undef PG8_STAGE
#undef PG8_LDA
#undef PG8_LDB
#undef PG8_MMA
#undef PG8_WAIT_V
#undef PG8_WAIT_L
#undef PG8_BAR
#undef PG8_SCHED
}

typedef const f32x4 (&AccRef)[2][2][4][2];

struct EpiSwiglu {
    static constexpr bool PERM = true;
    GAS bf16_t* O;
    __device__ __forceinline__ void operator()(AccRef acc, const Unit& u, int wr, int wc, int fr, int fq) const {
        const int row0 = u.pm * BM + wr * 64 + fr, col0 = u.pn * HALF + wc * 32 + 8 * fq;
#pragma unroll
        for (int ai = 0; ai < 2; ++ai)
#pragma unroll
            for (int m = 0; m < 4; ++m) {
                GAS bf16_t* rowp = O + (size_t)(row0 + ai * HALF + m * 16) * DFF + col0;
                const f32x4 g0 = acc[ai][0][m][0], g1 = acc[ai][0][m][1], u0 = acc[ai][1][m][0], u1 = acc[ai][1][m][1];
                u32x4 w;
                w.x = cvt_pk_bf16(siluf_(g0[0]) * u0[0], siluf_(g0[1]) * u0[1]); w.y = cvt_pk_bf16(siluf_(g0[2]) * u0[2], siluf_(g0[3]) * u0[3]);
                w.z = cvt_pk_bf16(siluf_(g1[0]) * u1[0], siluf_(g1[1]) * u1[1]); w.w = cvt_pk_bf16(siluf_(g1[2]) * u1[2], siluf_(g1[3]) * u1[3]);
                *(GAS u32x4*)rowp = w;
            }
    }
};

struct EpiY {
    static constexpr bool PERM = true;
    GAS bf16_t* Y; GAS const float* gate; float coef;
    __device__ __forceinline__ void operator()(AccRef acc, const Unit& u, int wr, int wc, int fr, int fq) const {
        const int row0 = u.pm * BM + wr * 64 + fr, col0 = u.pn * BM + wc * 32 + 8 * fq;
        GAS const float* gp = gate + (size_t)(u.pm >> 4) * NADA + col0;
        f32x4 gv[2][2];
#pragma unroll
        for (int bj = 0; bj < 2; ++bj)
#pragma unroll
            for (int n = 0; n < 2; ++n) gv[bj][n] = *(GAS const f32x4*)(gp + bj * HALF + n * 4) * coef;
#pragma unroll
        for (int ai = 0; ai < 2; ++ai)
#pragma unroll
            for (int m = 0; m < 4; ++m) {
                GAS bf16_t* rowp = Y + (size_t)(row0 + ai * HALF + m * 16) * D + col0;
#pragma unroll
                for (int bj = 0; bj < 2; ++bj) {
                    const f32x4 v0 = acc[ai][bj][m][0] * gv[bj][0], v1 = acc[ai][bj][m][1] * gv[bj][1];
                    u32x4 w; w.x = cvt_pk_bf16(v0[0], v0[1]); w.y = cvt_pk_bf16(v0[2], v0[3]); w.z = cvt_pk_bf16(v1[0], v1[1]); w.w = cvt_pk_bf16(v1[2], v1[3]);
                    *(GAS u32x4*)(rowp + bj * HALF) = w;
                }
            }
    }
};

struct EpiZ {
    static constexpr bool PERM = true;
    GAS bf16_t* Z;
    __device__ __forceinline__ void operator()(AccRef acc, const Unit& u, int wr, int wc, int fr, int fq) const {
        const int row0 = u.pm * BM + wr * 64 + fr, col0 = u.pn * BM + wc * 32 + 8 * fq;
        const bool sg = u.pn >= 7;
#pragma unroll
        for (int ai = 0; ai < 2; ++ai)
#pragma unroll
            for (int m = 0; m < 4; ++m) {
                GAS bf16_t* rowp = Z + (size_t)(row0 + ai * HALF + m * 16) * NZ + col0;
#pragma unroll
                for (int bj = 0; bj < 2; ++bj) {
                    f32x4 v0 = acc[ai][bj][m][0], v1 = acc[ai][bj][m][1];
                    if (sg) {
#pragma unroll
                        for (int j = 0; j < 4; ++j) { v0[j] = sigmoidf_(v0[j]); v1[j] = sigmoidf_(v1[j]); }
                    }
                    u32x4 w; w.x = cvt_pk_bf16(v0[0], v0[1]); w.y = cvt_pk_bf16(v0[2], v0[3]); w.z = cvt_pk_bf16(v1[0], v1[1]); w.w = cvt_pk_bf16(v1[2], v1[3]);
                    *(GAS u32x4*)(rowp + bj * HALF) = w;
                }
            }
    }
};

struct EpiGate {
    static constexpr bool PERM = true;
    GAS const bf16_t* Z; GAS bf16_t* MX; int goff; int add;
    __device__ __forceinline__ void operator()(AccRef acc, const Unit& u, int wr, int wc, int fr, int fq) const {
        const int row0 = u.pm * BM + wr * 64 + fr, col0 = u.pn * BM + wc * 32 + 8 * fq;
#pragma unroll
        for (int ai = 0; ai < 2; ++ai)
#pragma unroll
            for (int m = 0; m < 4; ++m) {
                const size_t row = (size_t)(row0 + ai * HALF + m * 16);
#pragma unroll
                for (int bj = 0; bj < 2; ++bj) {
                    const u32x4 gz = *(GAS const u32x4*)(Z + row * NZ + goff + col0 + bj * HALF);
                    GAS bf16_t* op = MX + row * D + col0 + bj * HALF;
                    const f32x4 v0 = acc[ai][bj][m][0], v1 = acc[ai][bj][m][1];
                    float r[8];
                    r[0] = bf_lo(gz.x) * v0[0]; r[1] = bf_hi(gz.x) * v0[1]; r[2] = bf_lo(gz.y) * v0[2]; r[3] = bf_hi(gz.y) * v0[3];
                    r[4] = bf_lo(gz.z) * v1[0]; r[5] = bf_hi(gz.z) * v1[1]; r[6] = bf_lo(gz.w) * v1[2]; r[7] = bf_hi(gz.w) * v1[3];
                    if (add) { const u32x4 pv = *(GAS const u32x4*)op;
                        r[0] += bf_lo(pv.x); r[1] += bf_hi(pv.x); r[2] += bf_lo(pv.y); r[3] += bf_hi(pv.y); r[4] += bf_lo(pv.z); r[5] += bf_hi(pv.z); r[6] += bf_lo(pv.w); r[7] += bf_hi(pv.w); }
                    u32x4 w; w.x = cvt_pk_bf16(r[0], r[1]); w.y = cvt_pk_bf16(r[2], r[3]); w.z = cvt_pk_bf16(r[4], r[5]); w.w = cvt_pk_bf16(r[6], r[7]);
                    *(GAS u32x4*)op = w;
                }
            }
    }
};

struct EpiCmp1 {
    static constexpr bool PERM = true;
    GAS bf16_t* Hd;
    __device__ __forceinline__ void operator()(AccRef acc, const Unit& u, int wr, int wc, int fr, int fq) const {
        const int row0 = u.pm * BM + wr * 64 + fr, col0 = wc * 32 + 8 * fq;
#pragma unroll
        for (int ai = 0; ai < 2; ++ai)
#pragma unroll
            for (int m = 0; m < 4; ++m) {
                GAS bf16_t* rowp = Hd + (size_t)(row0 + ai * HALF + m * 16) * 256 + col0;
#pragma unroll
                for (int bj = 0; bj < 2; ++bj) {
                    const f32x4 v0 = acc[ai][bj][m][0], v1 = acc[ai][bj][m][1];
                    u32x4 w; w.x = cvt_pk_bf16(gelu_tanh(v0[0]), gelu_tanh(v0[1])); w.y = cvt_pk_bf16(gelu_tanh(v0[2]), gelu_tanh(v0[3]));
                    w.z = cvt_pk_bf16(gelu_tanh(v1[0]), gelu_tanh(v1[1])); w.w = cvt_pk_bf16(gelu_tanh(v1[2]), gelu_tanh(v1[3]));
                    *(GAS u32x4*)(rowp + bj * HALF) = w;
                }
            }
    }
};

struct EpiCmp2 {
    static constexpr bool PERM = true;
    GAS bf16_t* out; int tr;
    __device__ __forceinline__ void operator()(AccRef acc, const Unit& u, int wr, int wc, int fr, int fq) const {
        if (wc >= 2) return;
        const int row0 = u.pm * BM + wr * 64 + fr, col0 = wc * 32 + 8 * fq;
#pragma unroll
        for (int ai = 0; ai < 2; ++ai)
#pragma unroll
            for (int m = 0; m < 4; ++m) {
                const int row = row0 + ai * HALF + m * 16;
                const f32x4 v0 = acc[ai][0][m][0], v1 = acc[ai][0][m][1];
                u32x4 w; w.x = cvt_pk_bf16(v0[0], v0[1]); w.y = cvt_pk_bf16(v0[2], v0[3]); w.z = cvt_pk_bf16(v1[0], v1[1]); w.w = cvt_pk_bf16(v1[2], v1[3]);
                if (!tr) { *(GAS u32x4*)(out + (size_t)row * 64 + col0) = w; }
                else {
                    GAS bf16_t* base = out + ((size_t)(row >> 8) * 64 + col0) * 256 + (row & 255);
                    base[0 * 256] = (bf16_t)(w.x & 0xffffu); base[1 * 256] = (bf16_t)(w.x >> 16); base[2 * 256] = (bf16_t)(w.y & 0xffffu); base[3 * 256] = (bf16_t)(w.y >> 16);
                    base[4 * 256] = (bf16_t)(w.z & 0xffffu); base[5 * 256] = (bf16_t)(w.z >> 16); base[6 * 256] = (bf16_t)(w.w & 0xffffu); base[7 * 256] = (bf16_t)(w.w >> 16);
                }
            }
    }
};
}

__device__ __forceinline__ float wave_sum(float v) {
#pragma unroll
    for (int o = 1; o < 64; o <<= 1) v += __shfl_xor(v, o);
    return v;
}

__device__ __forceinline__ void tr_item(GAS const float* __restrict__ W, int N, GAS bf16_t* WT, int ldd, int map, LAS float* scr, int item, int nblk, int lane) {
    const int kb = item / nblk, nb = item % nblk, k0 = 64 * kb, n0 = 32 * nb;
    const int nd = n0 + (lane & 31);
    int sc;
    if (map == 0) sc = nd;
    else if (map == 1) { const int t = nd >> 8, r = nd & 255; sc = r < 128 ? 128 * t + r : DFF + 128 * t + (r - 128); }
    else if (map == 2) sc = nd < 1816 ? nd : (nd < 2048 ? -1 : nd - 232);
    else sc = nd < 64 ? nd : -1;
#pragma unroll
    for (int i = 0; i < 32; ++i) { const int kk = 2 * i + (lane >> 5); scr[kk * 33 + (lane & 31)] = sc >= 0 ? W[(size_t)(k0 + kk) * N + sc] : 0.f; }
    LDS_WAIT(); asm volatile("" ::: "memory");
    const int c = lane & 7;
#pragma unroll
    for (int j = 0; j < 4; ++j) { const int n = (lane >> 3) + 8 * j; const LAS float* s = scr + (8 * c) * 33 + n;
        u32x4 o; o.x = cvt_pk_bf16(s[0 * 33], s[1 * 33]); o.y = cvt_pk_bf16(s[2 * 33], s[3 * 33]); o.z = cvt_pk_bf16(s[4 * 33], s[5 * 33]); o.w = cvt_pk_bf16(s[6 * 33], s[7 * 33]);
        *(GAS u32x4*)(WT + (size_t)(n0 + n) * ldd + k0 + 8 * c) = o; }
    LDS_WAIT(); asm volatile("" ::: "memory");
}

template <bool WRITE_X, bool WRITE_H, bool ADD_Y, bool PRE_LN, bool SRC_BF16, bool X_BF16>
__device__ __forceinline__ void ln_rows(GAS const void* srcv, GAS const bf16_t* Y, GAS void* Xv, GAS bf16_t* H, GAS const float* __restrict__ lg, GAS const float* __restrict__ lb, GAS const float* ada, int modi,
                                        GAS const float* __restrict__ pg, GAS const float* __restrict__ pb, int gw, int NGW, int lane) {
    for (int row0 = 2 * gw; row0 < M; row0 += 2 * NGW) {
        f32x4 v[2][4]; u32x2 yv[2][4];
#pragma unroll
        for (int rr = 0; rr < 2; ++rr) {
            const int row = row0 + rr;
#pragma unroll
            for (int j = 0; j < 4; ++j) {
                if (SRC_BF16) { const u32x2 xb = ((GAS const u32x2*)((GAS const bf16_t*)srcv + (size_t)row * D) + lane)[64 * j]; v[rr][j] = (f32x4){bf_lo(xb.x), bf_hi(xb.x), bf_lo(xb.y), bf_hi(xb.y)}; }
                else v[rr][j] = ((GAS const f32x4*)((GAS const float*)srcv + (size_t)row * D) + lane)[64 * j];
                if (ADD_Y) yv[rr][j] = ((GAS const u32x2*)(Y + (size_t)row * D) + lane)[64 * j];
            }
        }
#pragma unroll
        for (int rr = 0; rr < 2; ++rr) {
            const int row = row0 + rr;
            if (PRE_LN) {
                float s = 0.f;
#pragma unroll
                for (int j = 0; j < 4; ++j) s += (v[rr][j].x + v[rr][j].y) + (v[rr][j].z + v[rr][j].w);
                const float mean = wave_sum(s) * (1.f / D); float s2 = 0.f;
#pragma unroll
                for (int j = 0; j < 4; ++j) { v[rr][j] = v[rr][j] - mean; s2 += (v[rr][j].x * v[rr][j].x + v[rr][j].y * v[rr][j].y) + (v[rr][j].z * v[rr][j].z + v[rr][j].w * v[rr][j].w); }
                const float rstd = 1.f / sqrtf(wave_sum(s2) * (1.f / D) + LN_EPS);
#pragma unroll
                for (int j = 0; j < 4; ++j) { const int col = 4 * lane + 256 * j; v[rr][j] = v[rr][j] * rstd * *(GAS const f32x4*)(pg + col) + *(GAS const f32x4*)(pb + col); }
            }
            float s = 0.f;
#pragma unroll
            for (int j = 0; j < 4; ++j) {
                if (ADD_Y) { const u32x2 y = yv[rr][j]; v[rr][j] = v[rr][j] * ALPHA + (f32x4){bf_lo(y.x), bf_hi(y.x), bf_lo(y.y), bf_hi(y.y)}; }
                s += (v[rr][j].x + v[rr][j].y) + (v[rr][j].z + v[rr][j].w);
            }
            const float mean = wave_sum(s) * (1.f / D); float s2 = 0.f;
#pragma unroll
            for (int j = 0; j < 4; ++j) { v[rr][j] = v[rr][j] - mean; s2 += (v[rr][j].x * v[rr][j].x + v[rr][j].y * v[rr][j].y) + (v[rr][j].z * v[rr][j].z + v[rr][j].w * v[rr][j].w); }
            const float rstd = 1.f / sqrtf(wave_sum(s2) * (1.f / D) + LN_EPS);
            GAS const float* ab = ada + (size_t)(row >> 12) * NADA + (size_t)modi * 3 * D;
            GAS u32x2* ho = (GAS u32x2*)(H + (size_t)row * D) + lane;
#pragma unroll
            for (int j = 0; j < 4; ++j) {
                const int col = 4 * lane + 256 * j;
                const f32x4 gg = *(GAS const f32x4*)(lg + col), bb = *(GAS const f32x4*)(lb + col);
                const f32x4 y = v[rr][j] * rstd * gg + bb;
                if (WRITE_X) {
                    if (X_BF16) { u32x2 w; w.x = cvt_pk_bf16(y.x, y.y); w.y = cvt_pk_bf16(y.z, y.w); ((GAS u32x2*)((GAS bf16_t*)Xv + (size_t)row * D) + lane)[64 * j] = w; }
                    else ((GAS f32x4*)((GAS float*)Xv + (size_t)row * D) + lane)[64 * j] = y;
                }
                if (WRITE_H) {
                    const f32x4 sh = *(GAS const f32x4*)(ab + col), sc = *(GAS const f32x4*)(ab + D + col);
                    const f32x4 h = y * (sc + 1.0f) + sh;
                    u32x2 w; w.x = cvt_pk_bf16(h.x, h.y); w.y = cvt_pk_bf16(h.z, h.w);
                    ho[64 * j] = w;
                }
            }
        }
    }
}

namespace att {
constexpr int SLOT_BYTES = 16384, NSLOT = 3;
constexpr int OFF_IMP = NSLOT * SLOT_BYTES;
constexpr int IMP_PITCH = 65;
constexpr int OFF_SCORE = OFF_IMP + 4 * 64 * IMP_PITCH * 4;
constexpr int OFF_SEL = OFF_SCORE + 64 * IMP_PITCH * 4;
constexpr int OFF_UN = OFF_SEL + 512;
constexpr int OFF_LIST = OFF_UN + 16;
constexpr float NEGV = -1e30f;
constexpr float C2 = 0.125f * LOG2E;

struct Src { GAS const bf16_t* k; GAS const bf16_t* v; int kpitch, vpitch; };

template <int MODE, bool INTERIOR>
__device__ __forceinline__ void tile_compute(const LAS unsigned char* Kb, const LAS unsigned char* Vb, const bf16x8 (&qf)[4], f32x16 (&o)[2], float& m, float& l, float inv_l,
                                             int tile, int t, float slope2, bool selbit, int qb, int ql, int hh, float (&prim)[8], float& carry) {
    const int swz4 = ((ql >> 1) & 7) << 4;
    bf16x8 kf[4][2];
#pragma unroll
    for (int ds = 0; ds < 4; ++ds) {
        kf[ds][0] = *(const LAS bf16x8*)(Kb + ql * 128 + (((ds * 2 + hh) << 4) ^ swz4));
        kf[ds][1] = *(const LAS bf16x8*)(Kb + (32 + ql) * 128 + (((ds * 2 + hh) << 4) ^ swz4));
    }
    __builtin_amdgcn_sched_barrier(0);
    f32x16 s[2];
    if (INTERIOR) {
        const float slopeC = slope2 * (1.0f / C2) * (MODE <= 1 ? 16.f : 1.f);
        float b0C = (MODE <= 1) ? slope2 * (1.0f / C2) * (float)(16 * (tile * 64 + 4 * hh) + 31 - t) : slopeC * (float)(tile * 64 + 4 * hh - t);
        if (MODE == 2 && !selbit) b0C = NEGV;
#pragma unroll
        for (int sub = 0; sub < 2; ++sub)
#pragma unroll
            for (int i = 0; i < 16; ++i) s[sub][i] = __builtin_fmaf(slopeC, (float)(sub * 32 + (i & 3) + 8 * (i >> 2)), b0C);
    } else {
#pragma unroll
        for (int i = 0; i < 16; ++i) { s[0][i] = 0.f; s[1][i] = 0.f; }
    }
#pragma unroll
    for (int ds = 0; ds < 4; ++ds) {
        s[0] = __builtin_amdgcn_mfma_f32_32x32x16_bf16(kf[ds][0], qf[ds], s[0], 0, 0, 0);
        s[1] = __builtin_amdgcn_mfma_f32_32x32x16_bf16(kf[ds][1], qf[ds], s[1], 0, 0, 0);
    }
    constexpr bool VPRE = INTERIOR && MODE >= 2;
    u32x2 vlo[4][2], vhi[4][2];
    if (VPRE) {
#pragma unroll
        for (int ks = 0; ks < 4; ++ks)
#pragma unroll
            for (int dsub = 0; dsub < 2; ++dsub) {
                const LAS unsigned char* vrow = Vb + (dsub * 32 + ql) * 128 + hh * 8;
                vlo[ks][dsub] = *(const LAS u32x2*)(vrow + (((ks * 2) << 4) ^ swz4)); vhi[ks][dsub] = *(const LAS u32x2*)(vrow + (((ks * 2 + 1) << 4) ^ swz4));
            }
        __builtin_amdgcn_sched_barrier(0);
    }
    float mx = NEGV;
    if (INTERIOR) {
#pragma unroll
        for (int sub = 0; sub < 2; ++sub)
#pragma unroll
            for (int i = 0; i < 16; ++i) { const float sv = s[sub][i] * C2; s[sub][i] = sv; mx = fmaxf(mx, sv); }
    } else {
        __builtin_amdgcn_sched_barrier(0);
        const float base = (MODE <= 1) ? (float)(t - 31 - 16 * (tile * 64 + 4 * hh)) : (float)(t - tile * 64 - 4 * hh);
        const float step = (MODE <= 1) ? 16.f : 1.f;
        const float nslope = -slope2;
#pragma unroll
        for (int sub = 0; sub < 2; ++sub)
#pragma unroll
            for (int i = 0; i < 16; ++i) {
                const float cpos = (float)(sub * 32 + (i & 3) + 8 * (i >> 2));
                const float dist = base - step * cpos;
                bool valid = dist >= 0.f;
                if (MODE == 2) valid = valid && selbit;
                if (MODE == 3) valid = valid && dist < 512.f;
                const float sv = valid ? __builtin_fmaf(s[sub][i], C2, nslope * dist) : NEGV;
                s[sub][i] = sv; mx = fmaxf(mx, sv);
            }
    }
    if (MODE != 1) {
        mx = fmaxf(mx, __shfl_xor(mx, 32));
        const float mn = fmaxf(m, mx);
        float rs = 0.f;
#pragma unroll
        for (int sub = 0; sub < 2; ++sub)
#pragma unroll
            for (int i = 0; i < 16; ++i) { const float sv = s[sub][i]; const float p = INTERIOR ? fast_exp2(sv - mn) : (sv > -1e29f ? fast_exp2(sv - mn) : 0.f); s[sub][i] = p; rs += p; }
        rs += __shfl_xor(rs, 32);
        if (__builtin_amdgcn_ballot_w64(mn > m) != 0ull) {
            const float alpha = fast_exp2(m - mn);
            l *= alpha;
            if (MODE != 0) {
#pragma unroll
                for (int i = 0; i < 16; ++i) { o[0][i] *= alpha; o[1][i] *= alpha; }
            }
        }
        l += rs; m = mn;
    } else {
#pragma unroll
        for (int sub = 0; sub < 2; ++sub)
#pragma unroll
            for (int i = 0; i < 16; ++i) { const float sv = s[sub][i]; s[sub][i] = (INTERIOR || sv > -1e29f) ? fast_exp2(sv - m) * inv_l : 0.f; }
        float sp[8];
#pragma unroll
        for (int k = 0; k < 8; ++k) { const int sub = k >> 2, i0 = (k & 3) * 4; prim[k] = (s[sub][i0] + s[sub][i0 + 1]) + (s[sub][i0 + 2] + s[sub][i0 + 3]); sp[k] = s[sub][i0 + 3]; }
        float x[8];
#pragma unroll
        for (int k = 0; k < 8; ++k) x[k] = __shfl_xor(sp[k], 32);
#pragma unroll
        for (int k = 0; k < 8; ++k) { const float fromlow = (k > 0) ? x[k > 0 ? k - 1 : 0] : carry; prim[k] += hh ? x[k] : fromlow; }
        carry = x[7];
    }
    if (MODE != 0) {
#pragma unroll
        for (int ks = 0; ks < 4; ++ks) {
            const int sub = ks >> 1, i0 = (ks & 1) * 8;
            union { u32x4 u; bf16x8 b; } pk;
            pk.u.x = cvt_pk_bf16(s[sub][i0 + 0], s[sub][i0 + 1]); pk.u.y = cvt_pk_bf16(s[sub][i0 + 2], s[sub][i0 + 3]);
            pk.u.z = cvt_pk_bf16(s[sub][i0 + 4], s[sub][i0 + 5]); pk.u.w = cvt_pk_bf16(s[sub][i0 + 6], s[sub][i0 + 7]);
#pragma unroll
            for (int dsub = 0; dsub < 2; ++dsub) {
                union { u32x4 u; bf16x8 b; } vf;
                const LAS unsigned char* vrow2 = Vb + (dsub * 32 + ql) * 128 + hh * 8;
                const u32x2 lo = VPRE ? vlo[ks][dsub] : *(const LAS u32x2*)(vrow2 + (((ks * 2) << 4) ^ swz4)), hi = VPRE ? vhi[ks][dsub] : *(const LAS u32x2*)(vrow2 + (((ks * 2 + 1) << 4) ^ swz4));
                vf.u.x = lo.x; vf.u.y = lo.y; vf.u.z = hi.x; vf.u.w = hi.y;
                o[dsub] = __builtin_amdgcn_mfma_f32_32x32x16_bf16(vf.b, pk.b, o[dsub], 0, 0, 0);
            }
        }
    }
}

__device__ __forceinline__ void attn_phase(LAS unsigned char* lds, GAS const bf16_t* Z, GAS const bf16_t* vTs, GAS const bf16_t* vTw, GAS const bf16_t* kc, GAS const bf16_t* vcT, GAS bf16_t* O, int G, int bid) {
    LAS float* imp = (LAS float*)(lds + OFF_IMP);
    LAS float* score = (LAS float*)(lds + OFF_SCORE);
    LAS unsigned char* selb = lds + OFF_SEL;
    LAS unsigned* un = (LAS unsigned*)(lds + OFF_UN);
    LAS unsigned short* tlist = (LAS unsigned short*)(lds + OFF_LIST);
    int cnt = 0;
#define ATT_ISSUE(desc_, k_) do { const int kd_ = (desc_) >> 8, tl_ = (desc_) & 255; \
        GAS const bf16_t* kg_; GAS const bf16_t* vg_; \
        if (kd_ <= 1) { kg_ = kc + ((size_t)bg * 256 + tl_ * 64) * 64 + okc; vg_ = vcT + (size_t)bg * 64 * 256 + tl_ * 64 + ovc; } \
        else if (kd_ <= 3) { kg_ = Z + ((size_t)b * SEQ + tl_ * 64) * NZ + ZC_KSLC + g * 64 + okz; vg_ = vTs + (size_t)bg * 64 * SEQ + tl_ * 64 + ovt; } \
        else { kg_ = Z + ((size_t)b * SEQ + tl_ * 64) * NZ + ZC_KWIN + g * 64 + okz; vg_ = vTw + (size_t)bg * 64 * SEQ + tl_ * 64 + ovt; } \
        LAS unsigned char* sl_ = lds + ((k_) % 3) * SLOT_BYTES + wave * 1024; \
        __builtin_amdgcn_global_load_lds((GAS const unsigned*)kg_, (LAS unsigned*)sl_, 16, 0, 0); \
        __builtin_amdgcn_global_load_lds((GAS const unsigned*)vg_, (LAS unsigned*)(sl_ + 8192), 16, 0, 0); } while (0)
    for (int uidx = bid; uidx < 2048; uidx += G) {
        int tid = threadIdx.x; asm volatile("" : "+v"(tid));
        const int wave = __builtin_amdgcn_readfirstlane(tid >> 6), lane = tid & 63;
        const int hg = wave >> 1, qh = wave & 1, ql = lane & 31, hh = lane >> 5;
        const int qrow = qh * 32 + ql;
        const int kk = uidx >> 8, bb = uidx & 255, r = bb >> 5, bg = (bb & 31) ^ (((kk + 1) >> 1) & 1);
        const int qb = 63 - 8 * kk - ((kk & 1) ? (7 - r) : r);
        const int b = bg >> 1, g = bg & 1;
        const int head = g * 4 + hg;
        const float slope2 = exp2f(-(float)(head + 1)) * LOG2E;
        const int t = qb * 64 + qrow;
        const size_t token = (size_t)b * SEQ + t;
        const int lrow = wave * 8 + (lane >> 3), cfetch = (lane & 7) ^ ((lrow >> 1) & 7);
        const int okc = lrow * 64 + cfetch * 8, ovc = lrow * 256 + cfetch * 8, okz = lrow * NZ + cfetch * 8, ovt = lrow * SEQ + cfetch * 8;
        if (tid < 2) un[tid] = 0u;
        bf16x8 qf[4];
#pragma unroll
        for (int ds = 0; ds < 4; ++ds) qf[ds] = *(GAS const bf16x8*)(Z + token * NZ + ZC_Q + head * 64 + ds * 16 + hh * 8);
        f32x16 o[2];
        LAS float* outst = (LAS float*)(lds + OFF_IMP) + wave * 2048 + lane;
        float prim[8]; float carry = 0.f;
        GAS const bf16_t* gzp = Z + token * NZ + ZC_GNSA + head * 3;
        const float gate0 = __uint_as_float((unsigned)gzp[0] << 16), gate1 = __uint_as_float((unsigned)gzp[1] << 16), gate2 = __uint_as_float((unsigned)gzp[2] << 16);
        float m = NEGV, l = 0.f, inv_l = 0.f;
        const int ntc = (qb >> 4) + 1, nA = 2 * ntc;
#define DESC_A(i_) ((i_) < ntc ? (i_) : (0x100 | ((i_) - ntc)))
        ATT_ISSUE(DESC_A(0), cnt); ATT_ISSUE(DESC_A(1), cnt + 1);
        for (int i = 0; i < nA; ++i) {
            if (i + 1 < nA) asm volatile("s_waitcnt vmcnt(2)" ::: "memory"); else asm volatile("s_waitcnt vmcnt(0)" ::: "memory");
            __builtin_amdgcn_s_barrier(); asm volatile("" ::: "memory");
            if (i + 2 < nA) ATT_ISSUE(DESC_A(i + 2), cnt + 2);
            const LAS unsigned char* Kb = lds + (cnt % 3) * SLOT_BYTES; const LAS unsigned char* Vb = Kb + 8192;
            if (i < ntc) {
                if (1024 * i + 1039 <= 64 * qb) tile_compute<0, true>(Kb, Vb, qf, o, m, l, 0.f, i, t, slope2, true, qb, ql, hh, prim, carry);
                else tile_compute<0, false>(Kb, Vb, qf, o, m, l, 0.f, i, t, slope2, true, qb, ql, hh, prim, carry);
            } else {
                const int tc = i - ntc;
                if (tc == 0) {
                    inv_l = l > 0.f ? 1.0f / l : 0.f;
#pragma unroll
                    for (int e = 0; e < 16; ++e) { o[0][e] = 0.f; o[1][e] = 0.f; }
                }
                if (1024 * tc + 1039 <= 64 * qb) tile_compute<1, true>(Kb, Vb, qf, o, m, l, inv_l, tc, t, slope2, true, qb, ql, hh, prim, carry);
                else tile_compute<1, false>(Kb, Vb, qf, o, m, l, inv_l, tc, t, slope2, true, qb, ql, hh, prim, carry);
#pragma unroll
                for (int k = 0; k < 8; ++k) imp[(hg * 64 + qrow) * IMP_PITCH + tc * 16 + 2 * k + hh] = prim[k];
            }
            ++cnt;
        }
        __syncthreads();
        int tid2 = threadIdx.x; asm volatile("" : "+v"(tid2));
#pragma unroll
        for (int i = 0; i < 8; ++i) {
            const int idx = tid2 + 512 * i, q = idx >> 6, j = idx & 63;
            float sc;
            if (j > qb) sc = NEGV;
            else if (j == 0 || j == qb || j == qb - 1) sc = 1e9f;
            else sc = ((imp[(0 * 64 + q) * IMP_PITCH + j] + imp[(1 * 64 + q) * IMP_PITCH + j]) + imp[(2 * 64 + q) * IMP_PITCH + j]) + imp[(3 * 64 + q) * IMP_PITCH + j];
            score[q * IMP_PITCH + j] = sc;
        }
        __syncthreads();
        {
            const int q = tid2 >> 3, jb = tid2 & 7;
            unsigned long long ownk[8]; int rank[8];
#pragma unroll
            for (int e = 0; e < 8; ++e) { const float sv = score[q * IMP_PITCH + jb * 8 + e]; const unsigned u = sv > 0.f ? __float_as_uint(sv) : 0u; ownk[e] = ((unsigned long long)u << 6) | (unsigned)(63 - (jb * 8 + e)); rank[e] = 0; }
#pragma unroll 4
            for (int j2 = 0; j2 <= qb; ++j2) {
                const float v = score[q * IMP_PITCH + j2];
                const unsigned u = v > 0.f ? __float_as_uint(v) : 0u;
                const unsigned long long kj = ((unsigned long long)u << 6) | (unsigned)(63 - j2);
#pragma unroll
                for (int e = 0; e < 8; ++e) rank[e] += (kj > ownk[e]) ? 1 : 0;
            }
            unsigned byte = 0;
#pragma unroll
            for (int e = 0; e < 8; ++e) byte |= (rank[e] < 16 ? 1u : 0u) << e;
            selb[q * 8 + jb] = (unsigned char)byte;
            atomicOr((unsigned*)(un + (jb >> 2)), byte << (8 * (jb & 3)));
        }
        __syncthreads();
#pragma unroll
        for (int i = 0; i < 16; ++i) { outst[i * 64] = gate0 * o[0][i]; outst[(16 + i) * 64] = gate0 * o[1][i]; }
        const u32x2 selw = *(const LAS u32x2*)(selb + qrow * 8);
        const unsigned long long selmask = ((unsigned long long)selw.y << 32) | selw.x;
        unsigned long long unmask = ((unsigned long long)un[1] << 32) | un[0];
        unmask &= (qb >= 63) ? ~0ull : ((1ull << (qb + 1)) - 1ull);
        const int nslc = (int)__builtin_popcountll(unmask);
        const int j0 = qb >= 8 ? qb - 8 : 0;
        const int nB = nslc + (qb - j0 + 1);
        if (tid2 < 64) { if ((unmask >> tid2) & 1ull) { const int pos = (tid2 >= 63) ? 0 : (int)__builtin_popcountll(unmask >> (tid2 + 1)); tlist[pos] = (unsigned short)(((tid2 == qb) ? 0x300 : 0x200) | tid2); } }
        else if (tid2 < 73) { const int w = tid2 - 64, j = qb - w; if (j >= j0) tlist[nslc + w] = (unsigned short)(((j == qb || j == qb - 8) ? 0x500 : 0x400) | j); }
        __syncthreads();
#define DESC_B(i_) ((int)__builtin_amdgcn_readfirstlane((unsigned)tlist[(i_)]))
        m = NEGV; l = 0.f;
#pragma unroll
        for (int e = 0; e < 16; ++e) { o[0][e] = 0.f; o[1][e] = 0.f; }
        ATT_ISSUE(DESC_B(0), cnt); ATT_ISSUE(DESC_B(1), cnt + 1);
        for (int i = 0; i < nB; ++i) {
            if (i + 1 < nB) asm volatile("s_waitcnt vmcnt(2)" ::: "memory"); else asm volatile("s_waitcnt vmcnt(0)" ::: "memory");
            __builtin_amdgcn_s_barrier(); asm volatile("" ::: "memory");
            if (i + 2 < nB) { const int dn = DESC_B(i + 2); ATT_ISSUE(dn, cnt + 2); }
            const LAS unsigned char* Kb = lds + (cnt % 3) * SLOT_BYTES; const LAS unsigned char* Vb = Kb + 8192;
            const int dsc = DESC_B(i), kind = dsc >> 8, j = dsc & 255;
            if (i == nslc) {
                const float sc = l > 0.f ? gate1 / l : 0.f;
#pragma unroll
                for (int e = 0; e < 16; ++e) { outst[e * 64] += sc * o[0][e]; outst[(16 + e) * 64] += sc * o[1][e]; o[0][e] = 0.f; o[1][e] = 0.f; }
                m = NEGV; l = 0.f;
            }
            if (kind == 2) tile_compute<2, true>(Kb, Vb, qf, o, m, l, 0.f, j, t, slope2, ((selmask >> j) & 1ull) != 0ull, qb, ql, hh, prim, carry);
            else if (kind == 3) tile_compute<2, false>(Kb, Vb, qf, o, m, l, 0.f, j, t, slope2, ((selmask >> j) & 1ull) != 0ull, qb, ql, hh, prim, carry);
            else if (kind == 4) tile_compute<3, true>(Kb, Vb, qf, o, m, l, 0.f, j, t, slope2, true, qb, ql, hh, prim, carry);
            else tile_compute<3, false>(Kb, Vb, qf, o, m, l, 0.f, j, t, slope2, true, qb, ql, hh, prim, carry);
            ++cnt;
        }
        {
            const float sc = l > 0.f ? gate2 / l : 0.f;
#pragma unroll
            for (int e = 0; e < 16; ++e) { o[0][e] = outst[e * 64] + sc * o[0][e]; o[1][e] = outst[(16 + e) * 64] + sc * o[1][e]; }
        }
        GAS bf16_t* op = O + token * 512 + head * 64 + 4 * hh;
#pragma unroll
        for (int dsub = 0; dsub < 2; ++dsub)
#pragma unroll
            for (int i4 = 0; i4 < 4; ++i4) {
                u32x2 w; w.x = cvt_pk_bf16(o[dsub][4 * i4 + 0], o[dsub][4 * i4 + 1]); w.y = cvt_pk_bf16(o[dsub][4 * i4 + 2], o[dsub][4 * i4 + 3]);
                *(GAS u32x2*)(op + dsub * 32 + 8 * i4) = w;
            }
        __syncthreads();
    }
#undef ATT_ISSUE
#undef DESC_A
#undef DESC_B
}
}

struct Args { const float* in[28]; float* out; unsigned char* ws; };

constexpr int PTAB_OFF = 143360;
__device__ __forceinline__ GAS const float* karg(const LAS unsigned char* lds, int slot) {
    const LAS unsigned* pt = (const LAS unsigned*)(lds + PTAB_OFF) + 2 * slot;
    const unsigned lo = __builtin_amdgcn_readfirstlane(pt[0]), hi = __builtin_amdgcn_readfirstlane(pt[1]);
    return (GAS const float*)(((unsigned long long)hi << 32) | lo);
}
#define INP(i) karg(lds, i)
#define WSB(off) ((GAS bf16_t*)((GAS unsigned char*)karg(lds, 29) + (off)))
#define WSF(off) ((GAS float*)((GAS unsigned char*)karg(lds, 29) + (off)))
#define XOUT ((GAS float*)karg(lds, 28))

__global__ void __launch_bounds__(512, 2) mega_fwd(Args a) {
    extern __shared__ __attribute__((aligned(16))) unsigned char lds_raw[];
    LAS unsigned char* lds = (LAS unsigned char*)lds_raw;
    cg::grid_group grid = cg::this_grid();
    const int tid = threadIdx.x, lane = tid & 63, wave = __builtin_amdgcn_readfirstlane(tid >> 6);
    const int G = gridDim.x, bid = blockIdx.x;
    const int gw = bid * 8 + wave, NGW = G * 8;
    if (tid == 0) {
        LAS unsigned long long* pt = (LAS unsigned long long*)(lds + PTAB_OFF);
#pragma unroll
        for (int i = 0; i < 28; ++i) pt[i] = (unsigned long long)a.in[i];
        pt[28] = (unsigned long long)a.out; pt[29] = (unsigned long long)a.ws;
    }
    __syncthreads();

    {
        LAS float* cact = (LAS float*)lds;
        GAS const float* c = INP(1);
        for (int i = tid; i < NBATCH * D; i += 512) { const int bb = i >> 10, k = i & 1023; cact[k * 16 + bb] = siluf_(c[i]); }
        __syncthreads();
        for (int item = bid; item < NADA / 64; item += G) {
            const int j = item * 64 + lane; GAS const float* w = INP(4) + j + (size_t)(wave * 128) * NADA;
            float acc[16];
#pragma unroll
            for (int bb = 0; bb < 16; ++bb) acc[bb] = 0.f;
#pragma unroll 16
            for (int k = 0; k < 128; ++k) {
                const float wv = w[(size_t)k * NADA];
                const LAS f32x4* cp = (const LAS f32x4*)(cact + (wave * 128 + k) * 16);
                const f32x4 c0 = cp[0], c1 = cp[1], c2 = cp[2], c3 = cp[3];
                acc[0] += c0.x * wv; acc[1] += c0.y * wv; acc[2] += c0.z * wv; acc[3] += c0.w * wv;
                acc[4] += c1.x * wv; acc[5] += c1.y * wv; acc[6] += c1.z * wv; acc[7] += c1.w * wv;
                acc[8] += c2.x * wv; acc[9] += c2.y * wv; acc[10] += c2.z * wv; acc[11] += c2.w * wv;
                acc[12] += c3.x * wv; acc[13] += c3.y * wv; acc[14] += c3.z * wv; acc[15] += c3.w * wv;
            }
            LAS float* part = (LAS float*)(lds + 65536);
#pragma unroll
            for (int bb = 0; bb < 16; ++bb) part[wave * 1024 + bb * 64 + lane] = acc[bb];
            __syncthreads();
#pragma unroll
            for (int h = 0; h < 2; ++h) {
                const int bsel = (tid >> 6) + 8 * h, col = tid & 63;
                float sum = 0.f;
#pragma unroll
                for (int w8 = 0; w8 < 8; ++w8) sum += part[w8 * 1024 + bsel * 64 + col];
                WSF(WS_ADA)[(size_t)bsel * NADA + item * 64 + col] = sum + INP(5)[item * 64 + col];
            }
            __syncthreads();
        }
        LAS float* scr = (LAS float*)(lds + 65536 + wave * 8448);
        constexpr int I_WA = 1024;
        constexpr int I_IN = 16 * (2 * DFF / 32), I_OUT = (DFF / 64) * 32, I_MIX = 16 * (NZ / 32), I_WB = 8 * 32, I_MO = 16 * 32, I_C1 = 32 * 8, I_C2 = 4 * 8;
        constexpr int NITEMS = I_WA + 2 * I_IN + 2 * I_OUT + I_MIX + I_WB + I_MO + 2 * I_C1 + 2 * I_C2;
        for (int it = gw; it < NITEMS; it += NGW) {
            int r = it;
            if (r < I_WA) {
                const int gq = r >> 8, rem = r & 255, c0 = (rem >> 4) * 8, n0 = (rem & 15) * 64;
                GAS const float* pw = INP(11) + ((size_t)gq * 128 + c0) * 128; GAS const float* psc = INP(12) + gq * 128; GAS const float* wba = INP(19) + (size_t)gq * 128 * D + n0 + lane;
                float acc[8];
#pragma unroll
                for (int ci = 0; ci < 8; ++ci) acc[ci] = 0.f;
#pragma unroll 16
                for (int d = 0; d < 128; ++d) {
                    const float wv = wba[(size_t)d * D] * psc[d];
#pragma unroll
                    for (int ci = 0; ci < 8; ++ci) acc[ci] += pw[ci * 128 + d] * wv;
                }
                u32x4 o; o.x = cvt_pk_bf16(acc[0], acc[1]); o.y = cvt_pk_bf16(acc[2], acc[3]); o.z = cvt_pk_bf16(acc[4], acc[5]); o.w = cvt_pk_bf16(acc[6], acc[7]);
                *(GAS u32x4*)(WSB(WS_WA) + (size_t)(n0 + lane) * 512 + gq * 128 + c0) = o;
                continue;
            }
            r -= I_WA;
            if (r < I_IN) { tr_item(INP(6), 2 * DFF, WSB(WS_W1IN), D, 1, scr, r, 2 * DFF / 32, lane); continue; } r -= I_IN;
            if (r < I_IN) { tr_item(INP(24), 2 * DFF, WSB(WS_W2IN), D, 1, scr, r, 2 * DFF / 32, lane); continue; } r -= I_IN;
            if (r < I_OUT) { tr_item(INP(7), D, WSB(WS_W1OUT), DFF, 0, scr, r, 32, lane); continue; } r -= I_OUT;
            if (r < I_OUT) { tr_item(INP(25), D, WSB(WS_W2OUT), DFF, 0, scr, r, 32, lane); continue; } r -= I_OUT;
            if (r < I_MIX) { tr_item(INP(10), 3864, WSB(WS_WMIX), D, 2, scr, r, NZ / 32, lane); continue; } r -= I_MIX;
            if (r < I_WB) { tr_item(INP(20), D, WSB(WS_WB), 512, 0, scr, r, 32, lane); continue; } r -= I_WB;
            if (r < I_MO) { tr_item(INP(21), D, WSB(WS_WMO), D, 0, scr, r, 32, lane); continue; } r -= I_MO;
            if (r < I_C1) { tr_item(INP(14), 256, WSB(WS_CKW1), 2048, 0, scr, r, 8, lane); continue; } r -= I_C1;
            if (r < I_C1) { tr_item(INP(17), 256, WSB(WS_CVW1), 2048, 0, scr, r, 8, lane); continue; } r -= I_C1;
            if (r < I_C2) { tr_item(INP(15), 64, WSB(WS_CKW2), 256, 3, scr, r, 8, lane); continue; } r -= I_C2;
            tr_item(INP(18), 64, WSB(WS_CVW2), 256, 3, scr, r, 8, lane);
        }
    }
    grid.sync();
    ln_rows<false, true, false, false, false, false>(INP(0), WSB(WS_H), XOUT, WSB(WS_H), INP(2), INP(3), WSF(WS_ADA), 0, INP(2), INP(3), gw, NGW, lane);
    grid.sync();
    pg8::StaticOrder S;
#ifndef REP_G1
#define REP_G1 1
#endif
#pragma unroll 1
    for (int rep = 0; rep < REP_G1; ++rep)
    { pg8::Gemm g{WSB(WS_H), WSB(WS_W1IN), M, 2 * DFF, D, D, D}; S.init(M, 2 * DFF, G, bid); pg8::EpiSwiglu E{WSB(WS_ACT)}; pg8::gemm_phase(lds, g, S, E); }
    grid.sync();
    { pg8::Gemm g{WSB(WS_ACT), WSB(WS_W1OUT), M, D, DFF, DFF, DFF}; S.init(M, D, G, bid); pg8::EpiY E{WSB(WS_H), WSF(WS_ADA) + 2 * D, 0.5f}; pg8::gemm_phase(lds, g, S, E); }
    grid.sync();
    ln_rows<true, true, true, true, false, true>(INP(0), WSB(WS_H), XOUT, WSB(WS_H), INP(8), INP(9), WSF(WS_ADA), 1, INP(2), INP(3), gw, NGW, lane);
    grid.sync();
#if MIXER_MODE >= 1
    { pg8::Gemm g{WSB(WS_H), WSB(WS_WMIX), M, NZ, D, D, D}; S.init(M, NZ, G, bid); pg8::EpiZ E{WSB(WS_ACT)}; pg8::gemm_phase(lds, g, S, E); }
    grid.sync();
    {
        constexpr int I_DELTA = M / 32, I_VT = 2 * 32 * 64, I_BLK = 2 * 8192 / 4;
        LAS unsigned char* tsc = lds + wave * 9216;
        GAS const bf16_t* Zp = WSB(WS_ACT);
#define UNPK8(v_, f_) do { f_[0] = bf_lo(v_.x); f_[1] = bf_hi(v_.x); f_[2] = bf_lo(v_.y); f_[3] = bf_hi(v_.y); f_[4] = bf_lo(v_.z); f_[5] = bf_hi(v_.z); f_[6] = bf_lo(v_.w); f_[7] = bf_hi(v_.w); } while (0)
        for (int it = gw; it < I_DELTA + I_VT + I_BLK; it += NGW) {
            int r = it;
            if (r < I_DELTA) {
                const int tok0 = r * 32, tpos0 = tok0 & (SEQ - 1), w = 2 << (lane >> 4);
                GAS const bf16_t* zp = Zp + (size_t)tok0 * NZ + lane * 8;
                GAS bf16_t* dp = WSB(WS_DELTA) + (size_t)tok0 * 512 + lane * 8;
                float sum[8];
#pragma unroll
                for (int e = 0; e < 8; ++e) sum[e] = 0.f;
#pragma unroll
                for (int i = 1; i < 16; ++i) {
                    if (i < w && tpos0 - i >= 0) {
                        const u32x4 v = *(GAS const u32x4*)(zp - (long)i * NZ); float f[8]; UNPK8(v, f);
#pragma unroll
                        for (int e = 0; e < 8; ++e) sum[e] += f[e];
                    }
                }
#pragma unroll 1
                for (int s4 = 0; s4 < 32; s4 += 4) {
                    u32x4 cur[4], old[4];
#pragma unroll
                    for (int q = 0; q < 4; ++q) {
                        cur[q] = *(GAS const u32x4*)(zp + (long)(s4 + q) * NZ);
                        const int back = s4 + q - w + 1;
                        old[q] = (tpos0 + back >= 0) ? *(GAS const u32x4*)(zp + (long)back * NZ) : (u32x4){0u, 0u, 0u, 0u};
                    }
#pragma unroll
                    for (int q = 0; q < 4; ++q) {
                        float f[8], fo[8]; UNPK8(cur[q], f); UNPK8(old[q], fo);
                        const int tpos = tpos0 + s4 + q; const int cnt = (tpos + 1) < w ? (tpos + 1) : w;
                        const float ic = 1.0f / (float)cnt;
#pragma unroll
                        for (int e = 0; e < 8; ++e) sum[e] += f[e];
                        u32x4 o; o.x = cvt_pk_bf16(sum[0] * ic - f[0], sum[1] * ic - f[1]); o.y = cvt_pk_bf16(sum[2] * ic - f[2], sum[3] * ic - f[3]);
                        o.z = cvt_pk_bf16(sum[4] * ic - f[4], sum[5] * ic - f[5]); o.w = cvt_pk_bf16(sum[6] * ic - f[6], sum[7] * ic - f[7]);
                        *(GAS u32x4*)(dp + (size_t)(s4 + q) * 512) = o;
#pragma unroll
                        for (int e = 0; e < 8; ++e) sum[e] -= fo[e];
                    }
                }
                continue;
            }
            r -= I_DELTA;
            if (r < I_VT) {
                const int which = r >> 11, rem = r & 2047, bg = rem >> 6, tile = rem & 63, b = bg >> 1, g = bg & 1;
                GAS const bf16_t* src = Zp + ((size_t)b * SEQ + tile * 64) * NZ + (which ? ZC_VWIN : ZC_VSLC) + g * 64;
                GAS bf16_t* dst = (which ? WSB(WS_VTW) : WSB(WS_VTS)) + (size_t)bg * 64 * SEQ + tile * 64;
                u32x4 vv[8];
#pragma unroll
                for (int i = 0; i < 8; ++i) vv[i] = *(GAS const u32x4*)(src + (size_t)(i * 8 + (lane >> 3)) * NZ + (lane & 7) * 8);
#pragma unroll
                for (int i = 0; i < 8; ++i) {
                    const int row = i * 8 + (lane >> 3), ch = lane & 7; const u32x4 v = vv[i];
                    LAS bf16_t* tp = (LAS bf16_t*)tsc + (ch * 8) * 72 + row;
                    tp[0 * 72] = (bf16_t)(v.x & 0xffffu); tp[1 * 72] = (bf16_t)(v.x >> 16); tp[2 * 72] = (bf16_t)(v.y & 0xffffu); tp[3 * 72] = (bf16_t)(v.y >> 16);
                    tp[4 * 72] = (bf16_t)(v.z & 0xffffu); tp[5 * 72] = (bf16_t)(v.z >> 16); tp[6 * 72] = (bf16_t)(v.w & 0xffffu); tp[7 * 72] = (bf16_t)(v.w >> 16);
                }
                LDS_WAIT(); asm volatile("" ::: "memory");
#pragma unroll
                for (int i = 0; i < 8; ++i) {
                    const int d = i * 8 + (lane >> 3), ch = lane & 7;
                    const u32x4 v = *(const LAS u32x4*)(tsc + d * 144 + ch * 16);
                    *(GAS u32x4*)(dst + (size_t)d * SEQ + ch * 8) = v;
                }
                LDS_WAIT(); asm volatile("" ::: "memory");
                continue;
            }
            r -= I_VT;
            {
                const int which = r >> 11, rowbase = (r & 2047) * 4, bg = rowbase >> 8, b = bg >> 1, g = bg & 1;
                GAS const float* pos = which ? INP(16) : INP(13);
                GAS bf16_t* dst = (which ? WSB(WS_VBLK) : WSB(WS_KBLK)) + (size_t)rowbase * 2048;
                GAS const bf16_t* src = Zp + (size_t)b * SEQ * NZ + (which ? ZC_VCMP : ZC_KCMP) + g * 64;
                u32x4 vv[4][4];
#pragma unroll
                for (int rr = 0; rr < 4; ++rr) {
                    const int n = (rowbase + rr) & 255;
#pragma unroll
                    for (int i = 0; i < 4; ++i) {
                        const int ch = lane + 64 * i, pp = ch >> 3, dc = ch & 7;
                        vv[rr][i] = (n < 255) ? *(GAS const u32x4*)(src + (size_t)(16 * n + pp) * NZ + dc * 8) : (u32x4){0u, 0u, 0u, 0u};
                    }
                }
#pragma unroll
                for (int i = 0; i < 4; ++i) {
                    const int ch = lane + 64 * i, pp = ch >> 3, dc = ch & 7;
                    const f32x4 p0 = *(GAS const f32x4*)(pos + pp * 64 + dc * 8), p1 = *(GAS const f32x4*)(pos + pp * 64 + dc * 8 + 4);
#pragma unroll
                    for (int rr = 0; rr < 4; ++rr) {
                        const int n = (rowbase + rr) & 255; const u32x4 v = vv[rr][i];
                        u32x4 o = (u32x4){0u, 0u, 0u, 0u};
                        if (n < 255) {
                            o.x = cvt_pk_bf16(bf_lo(v.x) + p0.x, bf_hi(v.x) + p0.y); o.y = cvt_pk_bf16(bf_lo(v.y) + p0.z, bf_hi(v.y) + p0.w);
                            o.z = cvt_pk_bf16(bf_lo(v.z) + p1.x, bf_hi(v.z) + p1.y); o.w = cvt_pk_bf16(bf_lo(v.w) + p1.z, bf_hi(v.w) + p1.w);
                        }
                        *(GAS u32x4*)(dst + (size_t)rr * 2048 + ch * 8) = o;
                    }
                }
            }
        }
#undef UNPK8
    }
    grid.sync();
#if MIXER_MODE >= 2
#pragma unroll 1
    for (int s = 0; s < 2; ++s) {
        pg8::Gemm g{s ? WSB(WS_VBLK) : WSB(WS_KBLK), s ? WSB(WS_CVW1) : WSB(WS_CKW1), 8192, 256, 2048, 2048, 2048}; S.init(8192, 256, G, s ? (bid + G - 32) % G : bid);
        pg8::EpiCmp1 E{s ? WSB(WS_HIDV) : WSB(WS_HIDK)}; pg8::gemm_phase(lds, g, S, E);
    }
    __syncthreads();
#pragma unroll 1
    for (int s = 0; s < 2; ++s) {
        pg8::Gemm g{s ? WSB(WS_HIDV) : WSB(WS_HIDK), s ? WSB(WS_CVW2) : WSB(WS_CKW2), 8192, 256, 256, 256, 256}; S.init(8192, 256, G, s ? (bid + G - 32) % G : bid);
        pg8::EpiCmp2 E{s ? WSB(WS_VCT) : WSB(WS_KC), s}; pg8::gemm_phase(lds, g, S, E);
    }
    grid.sync();
#ifndef REP_ATT
#define REP_ATT 1
#endif
#pragma unroll 1
    for (int rep = 0; rep < REP_ATT; ++rep)
        att::attn_phase(lds, WSB(WS_ACT), WSB(WS_VTS), WSB(WS_VTW), WSB(WS_KC), WSB(WS_VCT), WSB(WS_O), G, bid);
    grid.sync();
#endif
    { pg8::Gemm g{WSB(WS_DELTA), WSB(WS_WA), M, D, 512, 512, 512}; S.init(M, D, G, bid); pg8::EpiGate E{WSB(WS_ACT), WSB(WS_H), ZC_GA, 0}; pg8::gemm_phase(lds, g, S, E); }
#if MIXER_MODE >= 2
    { pg8::Gemm g{WSB(WS_O), WSB(WS_WB), M, D, 512, 512, 512}; S.init(M, D, G, bid); pg8::EpiGate E{WSB(WS_ACT), WSB(WS_H), ZC_GB, 1}; pg8::gemm_phase(lds, g, S, E); }
#endif
    grid.sync();
    { pg8::Gemm g{WSB(WS_H), WSB(WS_WMO), M, D, D, D, D}; S.init(M, D, G, bid); pg8::EpiY E{WSB(WS_DELTA), WSF(WS_ADA) + 5 * D, 1.0f}; pg8::gemm_phase(lds, g, S, E); }
    grid.sync();
#else
    for (size_t i = (size_t)bid * 512 + tid; i < (size_t)M * D / 4; i += (size_t)G * 512) { f32x4 v = ((GAS f32x4*)XOUT)[i]; ((GAS f32x4*)XOUT)[i] = v * ALPHA; }
    grid.sync();
#endif
    ln_rows<true, true, true, false, true, true>(XOUT, WSB(WS_DELTA), WSB(WS_DELTA), WSB(WS_H), INP(22), INP(23), WSF(WS_ADA), 2, INP(2), INP(3), gw, NGW, lane);
    grid.sync();
    { pg8::Gemm g{WSB(WS_H), WSB(WS_W2IN), M, 2 * DFF, D, D, D}; S.init(M, 2 * DFF, G, bid); pg8::EpiSwiglu E{WSB(WS_ACT)}; pg8::gemm_phase(lds, g, S, E); }
    grid.sync();
    { pg8::Gemm g{WSB(WS_ACT), WSB(WS_W2OUT), M, D, DFF, DFF, DFF}; S.init(M, D, G, bid); pg8::EpiY E{WSB(WS_H), WSF(WS_ADA) + 8 * D, 0.5f}; pg8::gemm_phase(lds, g, S, E); }
    grid.sync();
    ln_rows<true, false, true, false, true, false>(WSB(WS_DELTA), WSB(WS_H), XOUT, WSB(WS_H), INP(26), INP(27), WSF(WS_ADA), 0, INP(2), INP(3), gw, NGW, lane);
}

extern "C" void kernel_launch(void* const* d_in, const int* in_sizes, int n_in, void* d_out, int out_size, void* d_ws, size_t ws_size, hipStream_t stream) {
    static int grid = 0;
    if (grid == 0) {
        if (n_in != 28 || out_size != M * D || ws_size < WS_END) { fprintf(stderr, "kernel_launch: unexpected shapes (n_in %d out %d ws %zu)\n", n_in, out_size, ws_size); grid = -1; return; }
        int dev = 0, cus = 0, per_cu = 0;
        hipGetDevice(&dev);
        hipDeviceGetAttribute(&cus, hipDeviceAttributeMultiprocessorCount, dev);
        if (hipFuncSetAttribute((const void*)mega_fwd, hipFuncAttributeMaxDynamicSharedMemorySize, LDS_BYTES) != hipSuccess) { fprintf(stderr, "kernel_launch: hipFuncSetAttribute failed\n"); grid = -1; return; }
        if (hipOccupancyMaxActiveBlocksPerMultiprocessor(&per_cu, (const void*)mega_fwd, 512, LDS_BYTES) != hipSuccess || per_cu < 1) { fprintf(stderr, "kernel_launch: occupancy query says %d\n", per_cu); per_cu = 1; }
        (void)hipGetLastError();
        grid = cus * per_cu;
    }
    if (grid < 0) return;
    Args a{};
    for (int i = 0; i < 28; ++i) a.in[i] = (const float*)d_in[i];
    a.out = (float*)d_out; a.ws = (unsigned char*)d_ws;
    void* args[] = {&a};
    hipError_t e = hipLaunchCooperativeKernel((const void*)mega_fwd, dim3(grid), dim3(512), args, LDS_BYTES, stream);
    if (e != hipSuccess) fprintf(stderr, "cooperative launch failed: %s (grid %d)\n", hipGetErrorString(e), grid);
}
```

```cpp
#include <hip/hip_runtime.h>
#include <hip/hip_cooperative_groups.h>
#include <cstdio>
#include <cstdint>
namespace cg = cooperative_groups;

#define LAS __attribute__((address_space(3)))
#define GAS __attribute__((address_space(1)))
typedef unsigned short bf16_t;
typedef short bf16x8 __attribute__((ext_vector_type(8)));
typedef float f32x4 __attribute__((ext_vector_type(4)));
typedef float f32x16 __attribute__((ext_vector_type(16)));
typedef unsigned u32x4 __attribute__((ext_vector_type(4)));
typedef unsigned u32x2 __attribute__((ext_vector_type(2)));

#ifndef MIXER_MODE
#define MIXER_MODE 2
#endif

constexpr int D = 1024, NBATCH = 16, SEQ = 4096, M = NBATCH * SEQ, DFF = 2816, NZ = 4096, NADA = 9 * D;
constexpr float ALPHA = 1.189207115002721f;
constexpr float LN_EPS = 1e-5f;
constexpr float LOG2E = 1.4426950408889634f;
constexpr int ZC_Q = 512, ZC_KCMP = 1024, ZC_VCMP = 1152, ZC_KSLC = 1280, ZC_VSLC = 1408, ZC_KWIN = 1536, ZC_VWIN = 1664, ZC_GNSA = 1792, ZC_GA = 2048, ZC_GB = 3072;

constexpr size_t MiB = 1u << 20;
constexpr size_t WS_ADA = 1 * MiB;
constexpr size_t WS_W1IN = 2 * MiB;
constexpr size_t WS_W1OUT = 13 * MiB;
constexpr size_t WS_W2IN = 19 * MiB;
constexpr size_t WS_W2OUT = 30 * MiB;
constexpr size_t WS_WMIX = 36 * MiB;
constexpr size_t WS_WA = 44 * MiB;
constexpr size_t WS_WB = 45 * MiB;
constexpr size_t WS_WMO = 46 * MiB;
constexpr size_t WS_CKW1 = 48 * MiB;
constexpr size_t WS_CVW1 = 49 * MiB;
constexpr size_t WS_CKW2 = 50 * MiB;
constexpr size_t WS_CVW2 = 50 * MiB + 512 * 1024;
constexpr size_t WS_KC = 51 * MiB;
constexpr size_t WS_VCT = 52 * MiB;
constexpr size_t WS_HIDK = 53 * MiB;
constexpr size_t WS_HIDV = 57 * MiB;
constexpr size_t WS_VTS = 64 * MiB;
constexpr size_t WS_VTW = 80 * MiB;
constexpr size_t WS_H = 96 * MiB;
constexpr size_t WS_DELTA = 224 * MiB;
constexpr size_t WS_O = 288 * MiB;
constexpr size_t WS_ACT = 352 * MiB;
constexpr size_t WS_KBLK = 864 * MiB;
constexpr size_t WS_VBLK = 896 * MiB;
constexpr size_t WS_END = 928 * MiB;

constexpr int LDS_BYTES = 147456;

__device__ __forceinline__ unsigned cvt_pk_bf16(float lo, float hi) { unsigned r; asm("v_cvt_pk_bf16_f32 %0, %1, %2" : "=v"(r) : "v"(lo), "v"(hi)); return r; }
__device__ __forceinline__ float bf_lo(unsigned u) { return __uint_as_float(u << 16); }
__device__ __forceinline__ float bf_hi(unsigned u) { return __uint_as_float(u & 0xffff0000u); }
__device__ __forceinline__ float fast_rcp(float x) { return __builtin_amdgcn_rcpf(x); }
__device__ __forceinline__ float fast_exp2(float x) { return __builtin_amdgcn_exp2f(x); }
__device__ __forceinline__ float sigmoidf_(float x) { return fast_rcp(1.0f + fast_exp2(-x * LOG2E)); }
__device__ __forceinline__ float siluf_(float x) { return x * sigmoidf_(x); }
__device__ __forceinline__ float gelu_tanh(float x) { const float u = 0.7978845608028654f * (x + 0.044715f * x * x * x); const float e = fast_exp2(2.0f * LOG2E * u); const float th = 1.0f - 2.0f * fast_rcp(e + 1.0f); return 0.5f * x * (1.0f + th); }
#define LDS_WAIT() asm volatile("s_waitcnt lgkmcnt(0)" ::: "memory")

namespace pg8 {
constexpr int BM = 256, BK = 64, HALF = 128, HTB = HALF * BK * 2, STAGE_BYTES = 8 * HTB, NXCD = 8, WGM = 8;
__host__ __device__ __forceinline__ int lds_byte(int r, int c) { const int st = (r >> 4) * 2 + (c >> 5), rr = r & 15, cc = c & 31, ob = rr * 64 + cc * 2; return st * 1024 + (ob ^ (((ob >> 9) & 1) << 5)); }
__host__ __device__ __forceinline__ void stage_rc(int b, int& R, int& C) { const int st = b / 1024, sb = b % 1024, swz = sb ^ (((sb >> 9) & 1) << 5); R = (st >> 1) * 16 + swz / 64; C = (st & 1) * 32 + (swz % 64) / 2; }
__host__ __device__ __forceinline__ int perm32(int rho) { const int n = rho >> 4, i = rho & 15; return 8 * (i >> 2) + 4 * n + (i & 3); }

struct Unit { int pm, pn; };
struct Gemm { GAS const bf16_t* A; GAS const bf16_t* Bt; int M, N, K, lda, ldb; };

struct StaticOrder {
    int nM, nN, nwg, G, c;
    __device__ void init(int M_, int N_, int G_, int c_) { nM = M_ / BM; nN = N_ / BM; nwg = nM * nN; G = G_; c = c_; }
    __device__ bool next(int i, Unit& u) const {
        const long L = (long)i * G + c; if (L >= nwg) return false;
        int wgid = (int)L; { const int q = nwg / NXCD, r = nwg % NXCD, xcd = wgid % NXCD, off = wgid / NXCD; wgid = (xcd < r ? xcd * (q + 1) : r * (q + 1) + (xcd - r) * q) + off; }
        const int nig = WGM * nN, gid = wgid / nig, fm = gid * WGM, gsz = (nM - fm) < WGM ? (nM - fm) : WGM;
        u.pm = fm + ((wgid % nig) % gsz); u.pn = (wgid % nig) / gsz; return true;
    }
};

template <class Epi>
__device__ __forceinline__ void gemm_phase(LAS unsigned char* lds, const Gemm g, const StaticOrder& S, const Epi& E) {
    int tid_ = threadIdx.x; asm volatile("" : "+v"(tid_));
    const int tid = tid_, wid = __builtin_amdgcn_readfirstlane(tid >> 6), lane = tid & 63, wr = wid >> 2, wc = wid & 3, fr = lane & 15, fq = lane >> 4;
    const int K = g.K, nt = K / BK;
    unsigned voffA[2], voffB[2];
#pragma unroll
    for (int i = 0; i < 2; ++i) { int R, C; stage_rc(tid * 16 + i * 8192, R, C); const int Rb = Epi::PERM ? ((R & ~31) + perm32(R & 31)) : R;
        voffA[i] = (unsigned)(R * g.lda + C) * 2u; voffB[i] = (unsigned)(Rb * g.ldb + C) * 2u; }
    const size_t kstep = (size_t)(BK * 2);
    const size_t hstepA = (size_t)HALF * g.lda * 2, hstepB = (size_t)HALF * g.ldb * 2;
    const size_t tstepA = 2 * hstepA, tstepB = 2 * hstepB;
    const unsigned ldsw = (unsigned)wid * 1024u;
    const int aoff = lds_byte(wr * 64 + fr, fq * 8), boff = lds_byte(wc * 32 + fr, fq * 8);
#define PG8_SA(b, h) (((b) * 2 + (h)) * HTB)
#define PG8_SB(b, h) ((4 + (b) * 2 + (h)) * HTB)
#define PG8_STAGE(bufoff, gbase, voff) do { _Pragma("unroll") for (int _i = 0; _i < 2; ++_i) \
        __builtin_amdgcn_global_load_lds((GAS const unsigned*)((gbase) + (voff)[_i]), (LAS unsigned*)(lds + (bufoff) + ldsw + _i * 8192), 16, 0, 0); } while (0)
#define PG8_LDA(dst, b, h) do { _Pragma("unroll") for (int m = 0; m < 4; ++m) _Pragma("unroll") for (int k = 0; k < 2; ++k) dst[m][k] = *(const LAS bf16x8*)(lds + PG8_SA(b, h) + aoff + m * 2048 + k * 1024); } while (0)
#define PG8_LDB(dst, b, h) do { _Pragma("unroll") for (int n = 0; n < 2; ++n) _Pragma("unroll") for (int k = 0; k < 2; ++k) dst[n][k] = *(const LAS bf16x8*)(lds + PG8_SB(b, h) + boff + n * 2048 + k * 1024); } while (0)
#define PG8_MMA(ai, bj, At, Bt) do { __builtin_amdgcn_s_setprio(1); _Pragma("unroll") for (int m = 0; m < 4; ++m) _Pragma("unroll") for (int n = 0; n < 2; ++n) _Pragma("unroll") for (int k = 0; k < 2; ++k) \
        acc[ai][bj][m][n] = __builtin_amdgcn_mfma_f32_16x16x32_bf16(Bt[n][k], At[m][k], acc[ai][bj][m][n], 0, 0, 0); __builtin_amdgcn_s_setprio(0); } while (0)
#define PG8_WAIT_V(n) asm volatile("s_waitcnt vmcnt(" #n ")" ::: "memory")
#define PG8_WAIT_L(n) asm volatile("s_waitcnt lgkmcnt(" #n ")" ::: "memory")
#define PG8_BAR __builtin_amdgcn_s_barrier()
#define PG8_SCHED __builtin_amdgcn_sched_barrier(0)
    Unit cur, nxt; int ui = 0;
    if (!S.next(0, cur)) return;
    f32x4 acc[2][2][4][2];
#pragma unroll
    for (int a = 0; a < 2; ++a)
#pragma unroll
        for (int b = 0; b < 2; ++b)
#pragma unroll
            for (int m = 0; m < 4; ++m)
#pragma unroll
                for (int n = 0; n < 2; ++n) acc[a][b][m][n] = (f32x4){0.f, 0.f, 0.f, 0.f};
    bf16x8 At[4][2], B0[2][2], B1[2][2];
    GAS const char* cA = (GAS const char*)g.A + (size_t)cur.pm * tstepA; GAS const char* cB = (GAS const char*)g.Bt + (size_t)cur.pn * tstepB;
    PG8_STAGE(PG8_SB(0, 0), cB, voffB); PG8_STAGE(PG8_SB(0, 1), cB + hstepB, voffB); PG8_STAGE(PG8_SA(0, 0), cA, voffA); PG8_STAGE(PG8_SA(0, 1), cA + hstepA, voffA);
    if (wr == 1) PG8_BAR;
    PG8_WAIT_V(2); PG8_BAR;
    PG8_STAGE(PG8_SB(1, 0), cB + kstep, voffB); PG8_STAGE(PG8_SA(1, 0), cA + kstep, voffA); PG8_STAGE(PG8_SB(1, 1), cB + hstepB + kstep, voffB);
    PG8_WAIT_V(6); PG8_BAR;
    for (;;) {
        const bool has_next = S.next(ui + 1, nxt);
        GAS const char* nA = has_next ? (GAS const char*)g.A + (size_t)nxt.pm * tstepA : cA; GAS const char* nB = has_next ? (GAS const char*)g.Bt + (size_t)nxt.pn * tstepB : cB;
        for (int t = 0; t < nt; t += 2) {
            const bool last = (t == nt - 2);
            GAS const char* a1 = cA + (size_t)(t + 1) * kstep;
            GAS const char* a2 = last ? nA : cA + (size_t)(t + 2) * kstep; GAS const char* b2 = last ? nB : cB + (size_t)(t + 2) * kstep;
            GAS const char* a3 = a2 + kstep; GAS const char* b3 = b2 + kstep;
            PG8_LDB(B0, 0, 0); PG8_LDB(B1, 0, 1); PG8_SCHED; PG8_LDA(At, 0, 0); PG8_STAGE(PG8_SA(1, 1), a1 + hstepA, voffA);
            PG8_WAIT_V(8); PG8_WAIT_L(0); PG8_BAR; PG8_MMA(0, 0, At, B0); PG8_MMA(0, 1, At, B1); PG8_BAR; PG8_SCHED;
            PG8_LDA(At, 0, 1); PG8_STAGE(PG8_SB(0, 0), b2, voffB); PG8_STAGE(PG8_SB(0, 1), b2 + hstepB, voffB); PG8_STAGE(PG8_SA(0, 0), a2, voffA);
            PG8_WAIT_V(8); PG8_WAIT_L(0); PG8_BAR; PG8_MMA(1, 0, At, B0); PG8_MMA(1, 1, At, B1); PG8_BAR; PG8_SCHED;
            PG8_LDB(B0, 1, 0); PG8_LDB(B1, 1, 1); PG8_SCHED; PG8_LDA(At, 1, 0); PG8_STAGE(PG8_SA(0, 1), a2 + hstepA, voffA);
            PG8_WAIT_V(8); PG8_WAIT_L(0); PG8_BAR; PG8_MMA(0, 0, At, B0); PG8_MMA(0, 1, At, B1); PG8_BAR; PG8_SCHED;
            PG8_LDA(At, 1, 1); PG8_STAGE(PG8_SB(1, 0), b3, voffB); PG8_STAGE(PG8_SB(1, 1), b3 + hstepB, voffB); PG8_STAGE(PG8_SA(1, 0), a3, voffA);
            PG8_WAIT_V(8); PG8_WAIT_L(0); PG8_BAR; PG8_MMA(1, 0, At, B0); PG8_MMA(1, 1, At, B1); PG8_BAR; PG8_SCHED;
        }
        if (wr == 0) PG8_BAR;
        E(acc, cur, wr, wc, fr, fq);
        if (!has_next) break;
#pragma unroll
        for (int a = 0; a < 2; ++a)
#pragma unroll
            for (int b = 0; b < 2; ++b)
#pragma unroll
                for (int m = 0; m < 4; ++m)
#pragma unroll
                    for (int n = 0; n < 2; ++n) acc[a][b][m][n] = (f32x4){0.f, 0.f, 0.f, 0.f};
        cur = nxt; cA = nA; cB = nB; ++ui;
        if (wr == 1) PG8_BAR;
    }
    PG8_WAIT_V(0);
    PG8_BAR;
#undef PG8_SA
#undef PG8_SB
#undef PG8_STAGE
#undef PG8_LDA
#undef PG8_LDB
#undef PG8_MMA
#undef PG8_WAIT_V
#undef PG8_WAIT_L
#undef PG8_BAR
#undef PG8_SCHED
}

typedef const f32x4 (&AccRef)[2][2][4][2];

struct EpiSwiglu {
    static constexpr bool PERM = true;
    GAS bf16_t* O;
    __device__ __forceinline__ void operator()(AccRef acc, const Unit& u, int wr, int wc, int fr, int fq) const {
        const int row0 = u.pm * BM + wr * 64 + fr, col0 = u.pn * HALF + wc * 32 + 8 * fq;
#pragma unroll
        for (int ai = 0; ai < 2; ++ai)
#pragma unroll
            for (int m = 0; m < 4; ++m) {
                GAS bf16_t* rowp = O + (size_t)(row0 + ai * HALF + m * 16) * DFF + col0;
                const f32x4 g0 = acc[ai][0][m][0], g1 = acc[ai][0][m][1], u0 = acc[ai][1][m][0], u1 = acc[ai][1][m][1];
                u32x4 w;
                w.x = cvt_pk_bf16(siluf_(g0[0]) * u0[0], siluf_(g0[1]) * u0[1]); w.y = cvt_pk_bf16(siluf_(g0[2]) * u0[2], siluf_(g0[3]) * u0[3]);
                w.z = cvt_pk_bf16(siluf_(g1[0]) * u1[0], siluf_(g1[1]) * u1[1]); w.w = cvt_pk_bf16(siluf_(g1[2]) * u1[2], siluf_(g1[3]) * u1[3]);
                *(GAS u32x4*)rowp = w;
            }
    }
};

struct EpiY {
    static constexpr bool PERM = true;
    GAS bf16_t* Y; GAS const float* gate; float coef;
    __device__ __forceinline__ void operator()(AccRef acc, const Unit& u, int wr, int wc, int fr, int fq) const {
        const int row0 = u.pm * BM + wr * 64 + fr, col0 = u.pn * BM + wc * 32 + 8 * fq;
        GAS const float* gp = gate + (size_t)(u.pm >> 4) * NADA + col0;
        f32x4 gv[2][2];
#pragma unroll
        for (int bj = 0; bj < 2; ++bj)
#pragma unroll
            for (int n = 0; n < 2; ++n) gv[bj][n] = *(GAS const f32x4*)(gp + bj * HALF + n * 4) * coef;
#pragma unroll
        for (int ai = 0; ai < 2; ++ai)
#pragma unroll
            for (int m = 0; m < 4; ++m) {
                GAS bf16_t* rowp = Y + (size_t)(row0 + ai * HALF + m * 16) * D + col0;
#pragma unroll
                for (int bj = 0; bj < 2; ++bj) {
                    const f32x4 v0 = acc[ai][bj][m][0] * gv[bj][0], v1 = acc[ai][bj][m][1] * gv[bj][1];
                    u32x4 w; w.x = cvt_pk_bf16(v0[0], v0[1]); w.y = cvt_pk_bf16(v0[2], v0[3]); w.z = cvt_pk_bf16(v1[0], v1[1]); w.w = cvt_pk_bf16(v1[2], v1[3]);
                    *(GAS u32x4*)(rowp + bj * HALF) = w;
                }
            }
    }
};

struct EpiZ {
    static constexpr bool PERM = true;
    GAS bf16_t* Z;
    __device__ __forceinline__ void operator()(AccRef acc, const Unit& u, int wr, int wc, int fr, int fq) const {
        const int row0 = u.pm * BM + wr * 64 + fr, col0 = u.pn * BM + wc * 32 + 8 * fq;
        const bool sg = u.pn >= 7;
#pragma unroll
        for (int ai = 0; ai < 2; ++ai)
#pragma unroll
            for (int m = 0; m < 4; ++m) {
                GAS bf16_t* rowp = Z + (size_t)(row0 + ai * HALF + m * 16) * NZ + col0;
#pragma unroll
                for (int bj = 0; bj < 2; ++bj) {
                    f32x4 v0 = acc[ai][bj][m][0], v1 = acc[ai][bj][m][1];
                    if (sg) {
#pragma unroll
                        for (int j = 0; j < 4; ++j) { v0[j] = sigmoidf_(v0[j]); v1[j] = sigmoidf_(v1[j]); }
                    }
                    u32x4 w; w.x = cvt_pk_bf16(v0[0], v0[1]); w.y = cvt_pk_bf16(v0[2], v0[3]); w.z = cvt_pk_bf16(v1[0], v1[1]); w.w = cvt_pk_bf16(v1[2], v1[3]);
                    *(GAS u32x4*)(rowp + bj * HALF) = w;
                }
            }
    }
};

struct EpiGate {
    static constexpr bool PERM = true;
    GAS const bf16_t* Z; GAS bf16_t* MX; int goff; int add;
    __device__ __forceinline__ void operator()(AccRef acc, const Unit& u, int wr, int wc, int fr, int fq) const {
        const int row0 = u.pm * BM + wr * 64 + fr, col0 = u.pn * BM + wc * 32 + 8 * fq;
#pragma unroll
        for (int ai = 0; ai < 2; ++ai)
#pragma unroll
            for (int m = 0; m < 4; ++m) {
                const size_t row = (size_t)(row0 + ai * HALF + m * 16);
#pragma unroll
                for (int bj = 0; bj < 2; ++bj) {
                    const u32x4 gz = *(GAS const u32x4*)(Z + row * NZ + goff + col0 + bj * HALF);
                    GAS bf16_t* op = MX + row * D + col0 + bj * HALF;
                    const f32x4 v0 = acc[ai][bj][m][0], v1 = acc[ai][bj][m][1];
                    float r[8];
                    r[0] = bf_lo(gz.x) * v0[0]; r[1] = bf_hi(gz.x) * v0[1]; r[2] = bf_lo(gz.y) * v0[2]; r[3] = bf_hi(gz.y) * v0[3];
                    r[4] = bf_lo(gz.z) * v1[0]; r[5] = bf_hi(gz.z) * v1[1]; r[6] = bf_lo(gz.w) * v1[2]; r[7] = bf_hi(gz.w) * v1[3];
                    if (add) { const u32x4 pv = *(GAS const u32x4*)op;
                        r[0] += bf_lo(pv.x); r[1] += bf_hi(pv.x); r[2] += bf_lo(pv.y); r[3] += bf_hi(pv.y); r[4] += bf_lo(pv.z); r[5] += bf_hi(pv.z); r[6] += bf_lo(pv.w); r[7] += bf_hi(pv.w); }
                    u32x4 w; w.x = cvt_pk_bf16(r[0], r[1]); w.y = cvt_pk_bf16(r[2], r[3]); w.z = cvt_pk_bf16(r[4], r[5]); w.w = cvt_pk_bf16(r[6], r[7]);
                    *(GAS u32x4*)op = w;
                }
            }
    }
};

struct EpiCmp1 {
    static constexpr bool PERM = true;
    GAS bf16_t* Hd;
    __device__ __forceinline__ void operator()(AccRef acc, const Unit& u, int wr, int wc, int fr, int fq) const {
        const int row0 = u.pm * BM + wr * 64 + fr, col0 = wc * 32 + 8 * fq;
#pragma unroll
        for (int ai = 0; ai < 2; ++ai)
#pragma unroll
            for (int m = 0; m < 4; ++m) {
                GAS bf16_t* rowp = Hd + (size_t)(row0 + ai * HALF + m * 16) * 256 + col0;
#pragma unroll
                for (int bj = 0; bj < 2; ++bj) {
                    const f32x4 v0 = acc[ai][bj][m][0], v1 = acc[ai][bj][m][1];
                    u32x4 w; w.x = cvt_pk_bf16(gelu_tanh(v0[0]), gelu_tanh(v0[1])); w.y = cvt_pk_bf16(gelu_tanh(v0[2]), gelu_tanh(v0[3]));
                    w.z = cvt_pk_bf16(gelu_tanh(v1[0]), gelu_tanh(v1[1])); w.w = cvt_pk_bf16(gelu_tanh(v1[2]), gelu_tanh(v1[3]));
                    *(GAS u32x4*)(rowp + bj * HALF) = w;
                }
            }
    }
};

struct EpiCmp2 {
    static constexpr bool PERM = true;
    GAS bf16_t* out; int tr;
    __device__ __forceinline__ void operator()(AccRef acc, const Unit& u, int wr, int wc, int fr, int fq) const {
        if (wc >= 2) return;
        const int row0 = u.pm * BM + wr * 64 + fr, col0 = wc * 32 + 8 * fq;
#pragma unroll
        for (int ai = 0; ai < 2; ++ai)
#pragma unroll
            for (int m = 0; m < 4; ++m) {
                const int row = row0 + ai * HALF + m * 16;
                const f32x4 v0 = acc[ai][0][m][0], v1 = acc[ai][0][m][1];
                u32x4 w; w.x = cvt_pk_bf16(v0[0], v0[1]); w.y = cvt_pk_bf16(v0[2], v0[3]); w.z = cvt_pk_bf16(v1[0], v1[1]); w.w = cvt_pk_bf16(v1[2], v1[3]);
                if (!tr) { *(GAS u32x4*)(out + (size_t)row * 64 + col0) = w; }
                else {
                    GAS bf16_t* base = out + ((size_t)(row >> 8) * 64 + col0) * 256 + (row & 255);
                    base[0 * 256] = (bf16_t)(w.x & 0xffffu); base[1 * 256] = (bf16_t)(w.x >> 16); base[2 * 256] = (bf16_t)(w.y & 0xffffu); base[3 * 256] = (bf16_t)(w.y >> 16);
                    base[4 * 256] = (bf16_t)(w.z & 0xffffu); base[5 * 256] = (bf16_t)(w.z >> 16); base[6 * 256] = (bf16_t)(w.w & 0xffffu); base[7 * 256] = (bf16_t)(w.w >> 16);
                }
            }
    }
};
}

__device__ __forceinline__ float wave_sum(float v) {
#pragma unroll
    for (int o = 1; o < 64; o <<= 1) v += __shfl_xor(v, o);
    return v;
}

__device__ __forceinline__ void tr_item(GAS const float* __restrict__ W, int N, GAS bf16_t* WT, int ldd, int map, LAS float* scr, int item, int nblk, int lane) {
    const int kb = item / nblk, nb = item % nblk, k0 = 64 * kb, n0 = 32 * nb;
    const int nd = n0 + (lane & 31);
    int sc;
    if (map == 0) sc = nd;
    else if (map == 1) { const int t = nd >> 8, r = nd & 255; sc = r < 128 ? 128 * t + r : DFF + 128 * t + (r - 128); }
    else if (map == 2) sc = nd < 1816 ? nd : (nd < 2048 ? -1 : nd - 232);
    else sc = nd < 64 ? nd : -1;
    const int scl = sc >= 0 ? sc : 0;
    float wv[32];
#pragma unroll
    for (int i = 0; i < 32; ++i) wv[i] = W[(size_t)(k0 + 2 * i + (lane >> 5)) * N + scl];
#pragma unroll
    for (int i = 0; i < 32; ++i) { const int kk = 2 * i + (lane >> 5); scr[kk * 33 + (lane & 31)] = sc >= 0 ? wv[i] : 0.f; }
    LDS_WAIT(); asm volatile("" ::: "memory");
    const int c = lane & 7;
#pragma unroll
    for (int j = 0; j < 4; ++j) { const int n = (lane >> 3) + 8 * j; const LAS float* s = scr + (8 * c) * 33 + n;
        u32x4 o; o.x = cvt_pk_bf16(s[0 * 33], s[1 * 33]); o.y = cvt_pk_bf16(s[2 * 33], s[3 * 33]); o.z = cvt_pk_bf16(s[4 * 33], s[5 * 33]); o.w = cvt_pk_bf16(s[6 * 33], s[7 * 33]);
        *(GAS u32x4*)(WT + (size_t)(n0 + n) * ldd + k0 + 8 * c) = o; }
    LDS_WAIT(); asm volatile("" ::: "memory");
}

template <bool WRITE_X, bool WRITE_H, bool ADD_Y, bool PRE_LN, bool SRC_BF16, bool X_BF16>
__device__ __forceinline__ void ln_rows(GAS const void* srcv, GAS const bf16_t* Y, GAS void* Xv, GAS bf16_t* H, GAS const float* __restrict__ lg, GAS const float* __restrict__ lb, GAS const float* ada, int modi,
                                        GAS const float* __restrict__ pg, GAS const float* __restrict__ pb, int gw, int NGW, int lane) {
    for (int row0 = 2 * gw; row0 < M; row0 += 2 * NGW) {
        f32x4 v[2][4]; u32x2 yv[2][4];
#pragma unroll
        for (int rr = 0; rr < 2; ++rr) {
            const int row = row0 + rr;
#pragma unroll
            for (int j = 0; j < 4; ++j) {
                if (SRC_BF16) { const u32x2 xb = ((GAS const u32x2*)((GAS const bf16_t*)srcv + (size_t)row * D) + lane)[64 * j]; v[rr][j] = (f32x4){bf_lo(xb.x), bf_hi(xb.x), bf_lo(xb.y), bf_hi(xb.y)}; }
                else v[rr][j] = ((GAS const f32x4*)((GAS const float*)srcv + (size_t)row * D) + lane)[64 * j];
                if (ADD_Y) yv[rr][j] = ((GAS const u32x2*)(Y + (size_t)row * D) + lane)[64 * j];
            }
        }
#pragma unroll
        for (int rr = 0; rr < 2; ++rr) {
            const int row = row0 + rr;
            if (PRE_LN) {
                float s = 0.f;
#pragma unroll
                for (int j = 0; j < 4; ++j) s += (v[rr][j].x + v[rr][j].y) + (v[rr][j].z + v[rr][j].w);
                const float mean = wave_sum(s) * (1.f / D); float s2 = 0.f;
#pragma unroll
                for (int j = 0; j < 4; ++j) { v[rr][j] = v[rr][j] - mean; s2 += (v[rr][j].x * v[rr][j].x + v[rr][j].y * v[rr][j].y) + (v[rr][j].z * v[rr][j].z + v[rr][j].w * v[rr][j].w); }
                const float rstd = 1.f / sqrtf(wave_sum(s2) * (1.f / D) + LN_EPS);
#pragma unroll
                for (int j = 0; j < 4; ++j) { const int col = 4 * lane + 256 * j; v[rr][j] = v[rr][j] * rstd * *(GAS const f32x4*)(pg + col) + *(GAS const f32x4*)(pb + col); }
            }
            float s = 0.f;
#pragma unroll
            for (int j = 0; j < 4; ++j) {
                if (ADD_Y) { const u32x2 y = yv[rr][j]; v[rr][j] = v[rr][j] * ALPHA + (f32x4){bf_lo(y.x), bf_hi(y.x), bf_lo(y.y), bf_hi(y.y)}; }
                s += (v[rr][j].x + v[rr][j].y) + (v[rr][j].z + v[rr][j].w);
            }
            const float mean = wave_sum(s) * (1.f / D); float s2 = 0.f;
#pragma unroll
            for (int j = 0; j < 4; ++j) { v[rr][j] = v[rr][j] - mean; s2 += (v[rr][j].x * v[rr][j].x + v[rr][j].y * v[rr][j].y) + (v[rr][j].z * v[rr][j].z + v[rr][j].w * v[rr][j].w); }
            const float rstd = 1.f / sqrtf(wave_sum(s2) * (1.f / D) + LN_EPS);
            GAS const float* ab = ada + (size_t)(row >> 12) * NADA + (size_t)modi * 3 * D;
            GAS u32x2* ho = (GAS u32x2*)(H + (size_t)row * D) + lane;
#pragma unroll
            for (int j = 0; j < 4; ++j) {
                const int col = 4 * lane + 256 * j;
                const f32x4 gg = *(GAS const f32x4*)(lg + col), bb = *(GAS const f32x4*)(lb + col);
                const f32x4 y = v[rr][j] * rstd * gg + bb;
                if (WRITE_X) {
                    if (X_BF16) { u32x2 w; w.x = cvt_pk_bf16(y.x, y.y); w.y = cvt_pk_bf16(y.z, y.w); ((GAS u32x2*)((GAS bf16_t*)Xv + (size_t)row * D) + lane)[64 * j] = w; }
                    else ((GAS f32x4*)((GAS float*)Xv + (size_t)row * D) + lane)[64 * j] = y;
                }
                if (WRITE_H) {
                    const f32x4 sh = *(GAS const f32x4*)(ab + col), sc = *(GAS const f32x4*)(ab + D + col);
                    const f32x4 h = y * (sc + 1.0f) + sh;
                    u32x2 w; w.x = cvt_pk_bf16(h.x, h.y); w.y = cvt_pk_bf16(h.z, h.w);
                    ho[64 * j] = w;
                }
            }
        }
    }
}

namespace att {
constexpr int SLOT_BYTES = 16384, NSLOT = 3;
constexpr int OFF_IMP = NSLOT * SLOT_BYTES;
constexpr int IMP_PITCH = 65;
constexpr int OFF_SCORE = OFF_IMP + 4 * 64 * IMP_PITCH * 4;
constexpr int OFF_SEL = OFF_SCORE + 64 * IMP_PITCH * 4;
constexpr int OFF_UN = OFF_SEL + 512;
constexpr int OFF_LIST = OFF_UN + 16;
constexpr float NEGV = -1e30f;
constexpr float C2 = 0.125f * LOG2E;

struct Src { GAS const bf16_t* k; GAS const bf16_t* v; int kpitch, vpitch; };

template <int MODE, bool INTERIOR>
__device__ __forceinline__ void tile_compute(const LAS unsigned char* Kb, const LAS unsigned char* Vb, const bf16x8 (&qf)[4], f32x16 (&o)[2], float& m, float& l, float inv_l,
                                             int tile, int t, float slope2, bool selbit, int qb, int ql, int hh, float (&prim)[8], float& carry) {
    const int swz4 = ((ql >> 1) & 7) << 4;
    bf16x8 kf[4][2];
#pragma unroll
    for (int ds = 0; ds < 4; ++ds) {
        kf[ds][0] = *(const LAS bf16x8*)(Kb + ql * 128 + (((ds * 2 + hh) << 4) ^ swz4));
        kf[ds][1] = *(const LAS bf16x8*)(Kb + (32 + ql) * 128 + (((ds * 2 + hh) << 4) ^ swz4));
    }
    __builtin_amdgcn_sched_barrier(0);
    f32x16 s[2];
    if (INTERIOR) {
        const float slopeC = slope2 * (1.0f / C2) * (MODE <= 1 ? 16.f : 1.f);
        float b0C = (MODE <= 1) ? slope2 * (1.0f / C2) * (float)(16 * (tile * 64 + 4 * hh) + 31 - t) : slopeC * (float)(tile * 64 + 4 * hh - t);
        if (MODE == 2 && !selbit) b0C = NEGV;
#pragma unroll
        for (int sub = 0; sub < 2; ++sub)
#pragma unroll
            for (int i = 0; i < 16; ++i) s[sub][i] = __builtin_fmaf(slopeC, (float)(sub * 32 + (i & 3) + 8 * (i >> 2)), b0C);
    } else {
#pragma unroll
        for (int i = 0; i < 16; ++i) { s[0][i] = 0.f; s[1][i] = 0.f; }
    }
#pragma unroll
    for (int ds = 0; ds < 4; ++ds) {
        s[0] = __builtin_amdgcn_mfma_f32_32x32x16_bf16(kf[ds][0], qf[ds], s[0], 0, 0, 0);
        s[1] = __builtin_amdgcn_mfma_f32_32x32x16_bf16(kf[ds][1], qf[ds], s[1], 0, 0, 0);
    }
    constexpr bool VPRE = INTERIOR && MODE >= 2;
    u32x2 vlo[4][2], vhi[4][2];
    if (VPRE) {
#pragma unroll
        for (int ks = 0; ks < 4; ++ks)
#pragma unroll
            for (int dsub = 0; dsub < 2; ++dsub) {
                const LAS unsigned char* vrow = Vb + (dsub * 32 + ql) * 128 + hh * 8;
                vlo[ks][dsub] = *(const LAS u32x2*)(vrow + (((ks * 2) << 4) ^ swz4)); vhi[ks][dsub] = *(const LAS u32x2*)(vrow + (((ks * 2 + 1) << 4) ^ swz4));
            }
        __builtin_amdgcn_sched_barrier(0);
    }
    float mx = NEGV;
    if (INTERIOR) {
#pragma unroll
        for (int sub = 0; sub < 2; ++sub)
#pragma unroll
            for (int i = 0; i < 16; ++i) { const float sv = s[sub][i] * C2; s[sub][i] = sv; mx = fmaxf(mx, sv); }
    } else {
        __builtin_amdgcn_sched_barrier(0);
        const float base = (MODE <= 1) ? (float)(t - 31 - 16 * (tile * 64 + 4 * hh)) : (float)(t - tile * 64 - 4 * hh);
        const float step = (MODE <= 1) ? 16.f : 1.f;
        const float nslope = -slope2;
#pragma unroll
        for (int sub = 0; sub < 2; ++sub)
#pragma unroll
            for (int i = 0; i < 16; ++i) {
                const float cpos = (float)(sub * 32 + (i & 3) + 8 * (i >> 2));
                const float dist = base - step * cpos;
                bool valid = dist >= 0.f;
                if (MODE == 2) valid = valid && selbit;
                if (MODE == 3) valid = valid && dist < 512.f;
                const float sv = valid ? __builtin_fmaf(s[sub][i], C2, nslope * dist) : NEGV;
                s[sub][i] = sv; mx = fmaxf(mx, sv);
            }
    }
    if (MODE != 1) {
        mx = fmaxf(mx, __shfl_xor(mx, 32));
        const float mn = fmaxf(m, mx);
        float rs = 0.f;
#pragma unroll
        for (int sub = 0; sub < 2; ++sub)
#pragma unroll
            for (int i = 0; i < 16; ++i) { const float sv = s[sub][i]; const float p = INTERIOR ? fast_exp2(sv - mn) : (sv > -1e29f ? fast_exp2(sv - mn) : 0.f); s[sub][i] = p; rs += p; }
        rs += __shfl_xor(rs, 32);
        if (__builtin_amdgcn_ballot_w64(mn > m) != 0ull) {
            const float alpha = fast_exp2(m - mn);
            l *= alpha;
            if (MODE != 0) {
#pragma unroll
                for (int i = 0; i < 16; ++i) { o[0][i] *= alpha; o[1][i] *= alpha; }
            }
        }
        l += rs; m = mn;
    } else {
#pragma unroll
        for (int sub = 0; sub < 2; ++sub)
#pragma unroll
            for (int i = 0; i < 16; ++i) { const float sv = s[sub][i]; s[sub][i] = (INTERIOR || sv > -1e29f) ? fast_exp2(sv - m) * inv_l : 0.f; }
        float sp[8];
#pragma unroll
        for (int k = 0; k < 8; ++k) { const int sub = k >> 2, i0 = (k & 3) * 4; prim[k] = (s[sub][i0] + s[sub][i0 + 1]) + (s[sub][i0 + 2] + s[sub][i0 + 3]); sp[k] = s[sub][i0 + 3]; }
        float x[8];
#pragma unroll
        for (int k = 0; k < 8; ++k) x[k] = __shfl_xor(sp[k], 32);
#pragma unroll
        for (int k = 0; k < 8; ++k) { const float fromlow = (k > 0) ? x[k > 0 ? k - 1 : 0] : carry; prim[k] += hh ? x[k] : fromlow; }
        carry = x[7];
    }
    if (MODE != 0) {
#pragma unroll
        for (int ks = 0; ks < 4; ++ks) {
            const int sub = ks >> 1, i0 = (ks & 1) * 8;
            union { u32x4 u; bf16x8 b; } pk;
            pk.u.x = cvt_pk_bf16(s[sub][i0 + 0], s[sub][i0 + 1]); pk.u.y = cvt_pk_bf16(s[sub][i0 + 2], s[sub][i0 + 3]);
            pk.u.z = cvt_pk_bf16(s[sub][i0 + 4], s[sub][i0 + 5]); pk.u.w = cvt_pk_bf16(s[sub][i0 + 6], s[sub][i0 + 7]);
#pragma unroll
            for (int dsub = 0; dsub < 2; ++dsub) {
                union { u32x4 u; bf16x8 b; } vf;
                const LAS unsigned char* vrow2 = Vb + (dsub * 32 + ql) * 128 + hh * 8;
                const u32x2 lo = VPRE ? vlo[ks][dsub] : *(const LAS u32x2*)(vrow2 + (((ks * 2) << 4) ^ swz4)), hi = VPRE ? vhi[ks][dsub] : *(const LAS u32x2*)(vrow2 + (((ks * 2 + 1) << 4) ^ swz4));
                vf.u.x = lo.x; vf.u.y = lo.y; vf.u.z = hi.x; vf.u.w = hi.y;
                o[dsub] = __builtin_amdgcn_mfma_f32_32x32x16_bf16(vf.b, pk.b, o[dsub], 0, 0, 0);
            }
        }
    }
}

__device__ __forceinline__ void attn_phase(LAS unsigned char* lds, GAS const bf16_t* Z, GAS const bf16_t* vTs, GAS const bf16_t* vTw, GAS const bf16_t* kc, GAS const bf16_t* vcT, GAS bf16_t* O, int G, int bid) {
    LAS float* imp = (LAS float*)(lds + OFF_IMP);
    LAS float* score = (LAS float*)(lds + OFF_SCORE);
    LAS unsigned char* selb = lds + OFF_SEL;
    LAS unsigned* un = (LAS unsigned*)(lds + OFF_UN);
    LAS unsigned short* tlist = (LAS unsigned short*)(lds + OFF_LIST);
    int cnt = 0;
#define ATT_ISSUE(desc_, k_) do { const int kd_ = (desc_) >> 8, tl_ = (desc_) & 255; \
        GAS const bf16_t* kg_; GAS const bf16_t* vg_; \
        if (kd_ <= 1) { kg_ = kc + ((size_t)bg * 256 + tl_ * 64) * 64 + okc; vg_ = vcT + (size_t)bg * 64 * 256 + tl_ * 64 + ovc; } \
        else if (kd_ <= 3) { kg_ = Z + ((size_t)b * SEQ + tl_ * 64) * NZ + ZC_KSLC + g * 64 + okz; vg_ = vTs + (size_t)bg * 64 * SEQ + tl_ * 64 + ovt; } \
        else { kg_ = Z + ((size_t)b * SEQ + tl_ * 64) * NZ + ZC_KWIN + g * 64 + okz; vg_ = vTw + (size_t)bg * 64 * SEQ + tl_ * 64 + ovt; } \
        LAS unsigned char* sl_ = lds + ((k_) % 3) * SLOT_BYTES + wave * 1024; \
        __builtin_amdgcn_global_load_lds((GAS const unsigned*)kg_, (LAS unsigned*)sl_, 16, 0, 0); \
        __builtin_amdgcn_global_load_lds((GAS const unsigned*)vg_, (LAS unsigned*)(sl_ + 8192), 16, 0, 0); } while (0)
    for (int uidx = bid; uidx < 2048; uidx += G) {
        int tid = threadIdx.x; asm volatile("" : "+v"(tid));
        const int wave = __builtin_amdgcn_readfirstlane(tid >> 6), lane = tid & 63;
        const int hg = wave >> 1, qh = wave & 1, ql = lane & 31, hh = lane >> 5;
        const int qrow = qh * 32 + ql;
        const int kk = uidx >> 8, bb = uidx & 255, r = bb >> 5, bg = (bb & 31) ^ (((kk + 1) >> 1) & 1);
        const int qb = 63 - 8 * kk - ((kk & 1) ? (7 - r) : r);
        const int b = bg >> 1, g = bg & 1;
        const int head = g * 4 + hg;
        const float slope2 = exp2f(-(float)(head + 1)) * LOG2E;
        const int t = qb * 64 + qrow;
        const size_t token = (size_t)b * SEQ + t;
        const int lrow = wave * 8 + (lane >> 3), cfetch = (lane & 7) ^ ((lrow >> 1) & 7);
        const int okc = lrow * 64 + cfetch * 8, ovc = lrow * 256 + cfetch * 8, okz = lrow * NZ + cfetch * 8, ovt = lrow * SEQ + cfetch * 8;
        if (tid < 2) un[tid] = 0u;
        bf16x8 qf[4];
#pragma unroll
        for (int ds = 0; ds < 4; ++ds) qf[ds] = *(GAS const bf16x8*)(Z + token * NZ + ZC_Q + head * 64 + ds * 16 + hh * 8);
        f32x16 o[2];
        LAS float* outst = (LAS float*)(lds + OFF_IMP) + wave * 2048 + lane;
        float prim[8]; float carry = 0.f;
        GAS const bf16_t* gzp = Z + token * NZ + ZC_GNSA + head * 3;
        const float gate0 = __uint_as_float((unsigned)gzp[0] << 16), gate1 = __uint_as_float((unsigned)gzp[1] << 16), gate2 = __uint_as_float((unsigned)gzp[2] << 16);
        float m = NEGV, l = 0.f, inv_l = 0.f;
        const int ntc = (qb >> 4) + 1, nA = 2 * ntc;
#define DESC_A(i_) ((i_) < ntc ? (i_) : (0x100 | ((i_) - ntc)))
        ATT_ISSUE(DESC_A(0), cnt); ATT_ISSUE(DESC_A(1), cnt + 1);
        for (int i = 0; i < nA; ++i) {
            if (i + 1 < nA) asm volatile("s_waitcnt vmcnt(2)" ::: "memory"); else asm volatile("s_waitcnt vmcnt(0)" ::: "memory");
            __builtin_amdgcn_s_barrier(); asm volatile("" ::: "memory");
            if (i + 2 < nA) ATT_ISSUE(DESC_A(i + 2), cnt + 2);
            const LAS unsigned char* Kb = lds + (cnt % 3) * SLOT_BYTES; const LAS unsigned char* Vb = Kb + 8192;
            if (i < ntc) {
                if (1024 * i + 1039 <= 64 * qb) tile_compute<0, true>(Kb, Vb, qf, o, m, l, 0.f, i, t, slope2, true, qb, ql, hh, prim, carry);
                else tile_compute<0, false>(Kb, Vb, qf, o, m, l, 0.f, i, t, slope2, true, qb, ql, hh, prim, carry);
            } else {
                const int tc = i - ntc;
                if (tc == 0) {
                    inv_l = l > 0.f ? 1.0f / l : 0.f;
#pragma unroll
                    for (int e = 0; e < 16; ++e) { o[0][e] = 0.f; o[1][e] = 0.f; }
                }
                if (1024 * tc + 1039 <= 64 * qb) tile_compute<1, true>(Kb, Vb, qf, o, m, l, inv_l, tc, t, slope2, true, qb, ql, hh, prim, carry);
                else tile_compute<1, false>(Kb, Vb, qf, o, m, l, inv_l, tc, t, slope2, true, qb, ql, hh, prim, carry);
#pragma unroll
                for (int k = 0; k < 8; ++k) imp[(hg * 64 + qrow) * IMP_PITCH + tc * 16 + 2 * k + hh] = prim[k];
            }
            ++cnt;
        }
        __syncthreads();
        int tid2 = threadIdx.x; asm volatile("" : "+v"(tid2));
#pragma unroll
        for (int i = 0; i < 8; ++i) {
            const int idx = tid2 + 512 * i, q = idx >> 6, j = idx & 63;
            float sc;
            if (j > qb) sc = NEGV;
            else if (j == 0 || j == qb || j == qb - 1) sc = 1e9f;
            else sc = ((imp[(0 * 64 + q) * IMP_PITCH + j] + imp[(1 * 64 + q) * IMP_PITCH + j]) + imp[(2 * 64 + q) * IMP_PITCH + j]) + imp[(3 * 64 + q) * IMP_PITCH + j];
            score[q * IMP_PITCH + j] = sc;
        }
        __syncthreads();
        {
            const int q = tid2 >> 3, jb = tid2 & 7;
            unsigned long long ownk[8]; int rank[8];
#pragma unroll
            for (int e = 0; e < 8; ++e) { const float sv = score[q * IMP_PITCH + jb * 8 + e]; const unsigned u = sv > 0.f ? __float_as_uint(sv) : 0u; ownk[e] = ((unsigned long long)u << 6) | (unsigned)(63 - (jb * 8 + e)); rank[e] = 0; }
#pragma unroll 4
            for (int j2 = 0; j2 <= qb; ++j2) {
                const float v = score[q * IMP_PITCH + j2];
                const unsigned u = v > 0.f ? __float_as_uint(v) : 0u;
                const unsigned long long kj = ((unsigned long long)u << 6) | (unsigned)(63 - j2);
#pragma unroll
                for (int e = 0; e < 8; ++e) rank[e] += (kj > ownk[e]) ? 1 : 0;
            }
            unsigned byte = 0;
#pragma unroll
            for (int e = 0; e < 8; ++e) byte |= (rank[e] < 16 ? 1u : 0u) << e;
            selb[q * 8 + jb] = (unsigned char)byte;
            atomicOr((unsigned*)(un + (jb >> 2)), byte << (8 * (jb & 3)));
        }
        __syncthreads();
#pragma unroll
        for (int i = 0; i < 16; ++i) { outst[i * 64] = gate0 * o[0][i]; outst[(16 + i) * 64] = gate0 * o[1][i]; }
        const u32x2 selw = *(const LAS u32x2*)(selb + qrow * 8);
        const unsigned long long selmask = ((unsigned long long)selw.y << 32) | selw.x;
        unsigned long long unmask = ((unsigned long long)un[1] << 32) | un[0];
        unmask &= (qb >= 63) ? ~0ull : ((1ull << (qb + 1)) - 1ull);
        const int nslc = (int)__builtin_popcountll(unmask);
        const int j0 = qb >= 8 ? qb - 8 : 0;
        const int nB = nslc + (qb - j0 + 1);
        if (tid2 < 64) { if ((unmask >> tid2) & 1ull) { const int pos = (tid2 >= 63) ? 0 : (int)__builtin_popcountll(unmask >> (tid2 + 1)); tlist[pos] = (unsigned short)(((tid2 == qb) ? 0x300 : 0x200) | tid2); } }
        else if (tid2 < 73) { const int w = tid2 - 64, j = qb - w; if (j >= j0) tlist[nslc + w] = (unsigned short)(((j == qb || j == qb - 8) ? 0x500 : 0x400) | j); }
        __syncthreads();
#define DESC_B(i_) ((int)__builtin_amdgcn_readfirstlane((unsigned)tlist[(i_)]))
        m = NEGV; l = 0.f;
#pragma unroll
        for (int e = 0; e < 16; ++e) { o[0][e] = 0.f; o[1][e] = 0.f; }
        ATT_ISSUE(DESC_B(0), cnt); ATT_ISSUE(DESC_B(1), cnt + 1);
        for (int i = 0; i < nB; ++i) {
            if (i + 1 < nB) asm volatile("s_waitcnt vmcnt(2)" ::: "memory"); else asm volatile("s_waitcnt vmcnt(0)" ::: "memory");
            __builtin_amdgcn_s_barrier(); asm volatile("" ::: "memory");
            if (i + 2 < nB) { const int dn = DESC_B(i + 2); ATT_ISSUE(dn, cnt + 2); }
            const LAS unsigned char* Kb = lds + (cnt % 3) * SLOT_BYTES; const LAS unsigned char* Vb = Kb + 8192;
            const int dsc = DESC_B(i), kind = dsc >> 8, j = dsc & 255;
            if (i == nslc) {
                const float sc = l > 0.f ? gate1 / l : 0.f;
#pragma unroll
                for (int e = 0; e < 16; ++e) { outst[e * 64] += sc * o[0][e]; outst[(16 + e) * 64] += sc * o[1][e]; o[0][e] = 0.f; o[1][e] = 0.f; }
                m = NEGV; l = 0.f;
            }
            if (kind == 2) tile_compute<2, true>(Kb, Vb, qf, o, m, l, 0.f, j, t, slope2, ((selmask >> j) & 1ull) != 0ull, qb, ql, hh, prim, carry);
            else if (kind == 3) tile_compute<2, false>(Kb, Vb, qf, o, m, l, 0.f, j, t, slope2, ((selmask >> j) & 1ull) != 0ull, qb, ql, hh, prim, carry);
            else if (kind == 4) tile_compute<3, true>(Kb, Vb, qf, o, m, l, 0.f, j, t, slope2, true, qb, ql, hh, prim, carry);
            else tile_compute<3, false>(Kb, Vb, qf, o, m, l, 0.f, j, t, slope2, true, qb, ql, hh, prim, carry);
            ++cnt;
        }
        {
            const float sc = l > 0.f ? gate2 / l : 0.f;
#pragma unroll
            for (int e = 0; e < 16; ++e) { o[0][e] = outst[e * 64] + sc * o[0][e]; o[1][e] = outst[(16 + e) * 64] + sc * o[1][e]; }
        }
        GAS bf16_t* op = O + token * 512 + head * 64 + 4 * hh;
#pragma unroll
        for (int dsub = 0; dsub < 2; ++dsub)
#pragma unroll
            for (int i4 = 0; i4 < 4; ++i4) {
                u32x2 w; w.x = cvt_pk_bf16(o[dsub][4 * i4 + 0], o[dsub][4 * i4 + 1]); w.y = cvt_pk_bf16(o[dsub][4 * i4 + 2], o[dsub][4 * i4 + 3]);
                *(GAS u32x2*)(op + dsub * 32 + 8 * i4) = w;
            }
        __syncthreads();
    }
#undef ATT_ISSUE
#undef DESC_A
#undef DESC_B
}
}

struct Args { const float* in[28]; float* out; unsigned char* ws; };

constexpr int PTAB_OFF = 143360;
__device__ __forceinline__ GAS const float* karg(const LAS unsigned char* lds, int slot) {
    const LAS unsigned* pt = (const LAS unsigned*)(lds + PTAB_OFF) + 2 * slot;
    const unsigned lo = __builtin_amdgcn_readfirstlane(pt[0]), hi = __builtin_amdgcn_readfirstlane(pt[1]);
    return (GAS const float*)(((unsigned long long)hi << 32) | lo);
}
#define INP(i) karg(lds, i)
#define WSB(off) ((GAS bf16_t*)((GAS unsigned char*)karg(lds, 29) + (off)))
#define WSF(off) ((GAS float*)((GAS unsigned char*)karg(lds, 29) + (off)))
#define XOUT ((GAS float*)karg(lds, 28))

__global__ void __launch_bounds__(512, 2) mega_fwd(Args a) {
    extern __shared__ __attribute__((aligned(16))) unsigned char lds_raw[];
    LAS unsigned char* lds = (LAS unsigned char*)lds_raw;
    cg::grid_group grid = cg::this_grid();
    const int tid = threadIdx.x, lane = tid & 63, wave = __builtin_amdgcn_readfirstlane(tid >> 6);
    const int G = gridDim.x, bid = blockIdx.x;
    const int gw = bid * 8 + wave, NGW = G * 8;
    if (tid == 0) {
        LAS unsigned long long* pt = (LAS unsigned long long*)(lds + PTAB_OFF);
#pragma unroll
        for (int i = 0; i < 28; ++i) pt[i] = (unsigned long long)a.in[i];
        pt[28] = (unsigned long long)a.out; pt[29] = (unsigned long long)a.ws;
    }
    __syncthreads();

    {
        LAS float* cact = (LAS float*)lds;
        GAS const float* c = INP(1);
        for (int i = tid; i < NBATCH * D; i += 512) { const int bb = i >> 10, k = i & 1023; cact[k * 16 + bb] = siluf_(c[i]); }
        __syncthreads();
        for (int item = bid; item < NADA / 64; item += G) {
            const int j = item * 64 + lane; GAS const float* w = INP(4) + j + (size_t)(wave * 128) * NADA;
            float acc[16];
#pragma unroll
            for (int bb = 0; bb < 16; ++bb) acc[bb] = 0.f;
#pragma unroll 16
            for (int k = 0; k < 128; ++k) {
                const float wv = w[(size_t)k * NADA];
                const LAS f32x4* cp = (const LAS f32x4*)(cact + (wave * 128 + k) * 16);
                const f32x4 c0 = cp[0], c1 = cp[1], c2 = cp[2], c3 = cp[3];
                acc[0] += c0.x * wv; acc[1] += c0.y * wv; acc[2] += c0.z * wv; acc[3] += c0.w * wv;
                acc[4] += c1.x * wv; acc[5] += c1.y * wv; acc[6] += c1.z * wv; acc[7] += c1.w * wv;
                acc[8] += c2.x * wv; acc[9] += c2.y * wv; acc[10] += c2.z * wv; acc[11] += c2.w * wv;
                acc[12] += c3.x * wv; acc[13] += c3.y * wv; acc[14] += c3.z * wv; acc[15] += c3.w * wv;
            }
            LAS float* part = (LAS float*)(lds + 65536);
#pragma unroll
            for (int bb = 0; bb < 16; ++bb) part[wave * 1024 + bb * 64 + lane] = acc[bb];
            __syncthreads();
#pragma unroll
            for (int h = 0; h < 2; ++h) {
                const int bsel = (tid >> 6) + 8 * h, col = tid & 63;
                float sum = 0.f;
#pragma unroll
                for (int w8 = 0; w8 < 8; ++w8) sum += part[w8 * 1024 + bsel * 64 + col];
                WSF(WS_ADA)[(size_t)bsel * NADA + item * 64 + col] = sum + INP(5)[item * 64 + col];
            }
            __syncthreads();
        }
        LAS float* scr = (LAS float*)(lds + 65536 + wave * 8448);
        constexpr int I_WA = 1024;
        constexpr int I_IN = 16 * (2 * DFF / 32), I_OUT = (DFF / 64) * 32, I_MIX = 16 * (NZ / 32), I_WB = 8 * 32, I_MO = 16 * 32, I_C1 = 32 * 8, I_C2 = 4 * 8;
        constexpr int NITEMS = I_WA + 2 * I_IN + 2 * I_OUT + I_MIX + I_WB + I_MO + 2 * I_C1 + 2 * I_C2;
        for (int it = gw; it < NITEMS; it += NGW) {
            int r = it;
            if (r < I_WA) {
                const int gq = r >> 8, rem = r & 255, c0 = (rem >> 4) * 8, n0 = (rem & 15) * 64;
                GAS const float* pw = INP(11) + ((size_t)gq * 128 + c0) * 128; GAS const float* psc = INP(12) + gq * 128; GAS const float* wba = INP(19) + (size_t)gq * 128 * D + n0 + lane;
                float acc[8];
#pragma unroll
                for (int ci = 0; ci < 8; ++ci) acc[ci] = 0.f;
#pragma unroll 16
                for (int d = 0; d < 128; ++d) {
                    const float wv = wba[(size_t)d * D] * psc[d];
#pragma unroll
                    for (int ci = 0; ci < 8; ++ci) acc[ci] += pw[ci * 128 + d] * wv;
                }
                u32x4 o; o.x = cvt_pk_bf16(acc[0], acc[1]); o.y = cvt_pk_bf16(acc[2], acc[3]); o.z = cvt_pk_bf16(acc[4], acc[5]); o.w = cvt_pk_bf16(acc[6], acc[7]);
                *(GAS u32x4*)(WSB(WS_WA) + (size_t)(n0 + lane) * 512 + gq * 128 + c0) = o;
                continue;
            }
            r -= I_WA;
            if (r < I_IN) { tr_item(INP(6), 2 * DFF, WSB(WS_W1IN), D, 1, scr, r, 2 * DFF / 32, lane); continue; } r -= I_IN;
            if (r < I_IN) { tr_item(INP(24), 2 * DFF, WSB(WS_W2IN), D, 1, scr, r, 2 * DFF / 32, lane); continue; } r -= I_IN;
            if (r < I_OUT) { tr_item(INP(7), D, WSB(WS_W1OUT), DFF, 0, scr, r, 32, lane); continue; } r -= I_OUT;
            if (r < I_OUT) { tr_item(INP(25), D, WSB(WS_W2OUT), DFF, 0, scr, r, 32, lane); continue; } r -= I_OUT;
            if (r < I_MIX) { tr_item(INP(10), 3864, WSB(WS_WMIX), D, 2, scr, r, NZ / 32, lane); continue; } r -= I_MIX;
            if (r < I_WB) { tr_item(INP(20), D, WSB(WS_WB), 512, 0, scr, r, 32, lane); continue; } r -= I_WB;
            if (r < I_MO) { tr_item(INP(21), D, WSB(WS_WMO), D, 0, scr, r, 32, lane); continue; } r -= I_MO;
            if (r < I_C1) { tr_item(INP(14), 256, WSB(WS_CKW1), 2048, 0, scr, r, 8, lane); continue; } r -= I_C1;
            if (r < I_C1) { tr_item(INP(17), 256, WSB(WS_CVW1), 2048, 0, scr, r, 8, lane); continue; } r -= I_C1;
            if (r < I_C2) { tr_item(INP(15), 64, WSB(WS_CKW2), 256, 3, scr, r, 8, lane); continue; } r -= I_C2;
            tr_item(INP(18), 64, WSB(WS_CVW2), 256, 3, scr, r, 8, lane);
        }
    }
    grid.sync();
    ln_rows<false, true, false, false, false, false>(INP(0), WSB(WS_H), XOUT, WSB(WS_H), INP(2), INP(3), WSF(WS_ADA), 0, INP(2), INP(3), gw, NGW, lane);
    grid.sync();
    pg8::StaticOrder S;
#ifndef REP_G1
#define REP_G1 1
#endif
#pragma unroll 1
    for (int rep = 0; rep < REP_G1; ++rep)
    { pg8::Gemm g{WSB(WS_H), WSB(WS_W1IN), M, 2 * DFF, D, D, D}; S.init(M, 2 * DFF, G, bid); pg8::EpiSwiglu E{WSB(WS_ACT)}; pg8::gemm_phase(lds, g, S, E); }
    grid.sync();
    { pg8::Gemm g{WSB(WS_ACT), WSB(WS_W1OUT), M, D, DFF, DFF, DFF}; S.init(M, D, G, bid); pg8::EpiY E{WSB(WS_H), WSF(WS_ADA) + 2 * D, 0.5f}; pg8::gemm_phase(lds, g, S, E); }
    grid.sync();
    ln_rows<true, true, true, true, false, true>(INP(0), WSB(WS_H), XOUT, WSB(WS_H), INP(8), INP(9), WSF(WS_ADA), 1, INP(2), INP(3), gw, NGW, lane);
    grid.sync();
#if MIXER_MODE >= 1
    { pg8::Gemm g{WSB(WS_H), WSB(WS_WMIX), M, NZ, D, D, D}; S.init(M, NZ, G, bid); pg8::EpiZ E{WSB(WS_ACT)}; pg8::gemm_phase(lds, g, S, E); }
    grid.sync();
    {
        constexpr int I_DELTA = M / 32, I_VT = 2 * 32 * 64, I_BLK = 2 * 8192 / 4;
        LAS unsigned char* tsc = lds + wave * 9216;
        GAS const bf16_t* Zp = WSB(WS_ACT);
#define UNPK8(v_, f_) do { f_[0] = bf_lo(v_.x); f_[1] = bf_hi(v_.x); f_[2] = bf_lo(v_.y); f_[3] = bf_hi(v_.y); f_[4] = bf_lo(v_.z); f_[5] = bf_hi(v_.z); f_[6] = bf_lo(v_.w); f_[7] = bf_hi(v_.w); } while (0)
        for (int it = gw; it < I_DELTA + I_VT + I_BLK; it += NGW) {
            int r = it;
            if (r < I_DELTA) {
                const int tok0 = r * 32, tpos0 = tok0 & (SEQ - 1), w = 2 << (lane >> 4);
                GAS const bf16_t* zp = Zp + (size_t)tok0 * NZ + lane * 8;
                GAS bf16_t* dp = WSB(WS_DELTA) + (size_t)tok0 * 512 + lane * 8;
                float sum[8];
#pragma unroll
                for (int e = 0; e < 8; ++e) sum[e] = 0.f;
#pragma unroll
                for (int i = 1; i < 16; ++i) {
                    if (i < w && tpos0 - i >= 0) {
                        const u32x4 v = *(GAS const u32x4*)(zp - (long)i * NZ); float f[8]; UNPK8(v, f);
#pragma unroll
                        for (int e = 0; e < 8; ++e) sum[e] += f[e];
                    }
                }
#pragma unroll 1
                for (int s4 = 0; s4 < 32; s4 += 4) {
                    u32x4 cur[4], old[4];
#pragma unroll
                    for (int q = 0; q < 4; ++q) {
                        cur[q] = *(GAS const u32x4*)(zp + (long)(s4 + q) * NZ);
                        const int back = s4 + q - w + 1;
                        old[q] = (tpos0 + back >= 0) ? *(GAS const u32x4*)(zp + (long)back * NZ) : (u32x4){0u, 0u, 0u, 0u};
                    }
#pragma unroll
                    for (int q = 0; q < 4; ++q) {
                        float f[8], fo[8]; UNPK8(cur[q], f); UNPK8(old[q], fo);
                        const int tpos = tpos0 + s4 + q; const int cnt = (tpos + 1) < w ? (tpos + 1) : w;
                        const float ic = 1.0f / (float)cnt;
#pragma unroll
                        for (int e = 0; e < 8; ++e) sum[e] += f[e];
                        u32x4 o; o.x = cvt_pk_bf16(sum[0] * ic - f[0], sum[1] * ic - f[1]); o.y = cvt_pk_bf16(sum[2] * ic - f[2], sum[3] * ic - f[3]);
                        o.z = cvt_pk_bf16(sum[4] * ic - f[4], sum[5] * ic - f[5]); o.w = cvt_pk_bf16(sum[6] * ic - f[6], sum[7] * ic - f[7]);
                        *(GAS u32x4*)(dp + (size_t)(s4 + q) * 512) = o;
#pragma unroll
                        for (int e = 0; e < 8; ++e) sum[e] -= fo[e];
                    }
                }
                continue;
            }
            r -= I_DELTA;
            if (r < I_VT) {
                const int which = r >> 11, rem = r & 2047, bg = rem >> 6, tile = rem & 63, b = bg >> 1, g = bg & 1;
                GAS const bf16_t* src = Zp + ((size_t)b * SEQ + tile * 64) * NZ + (which ? ZC_VWIN : ZC_VSLC) + g * 64;
                GAS bf16_t* dst = (which ? WSB(WS_VTW) : WSB(WS_VTS)) + (size_t)bg * 64 * SEQ + tile * 64;
                u32x4 vv[8];
#pragma unroll
                for (int i = 0; i < 8; ++i) vv[i] = *(GAS const u32x4*)(src + (size_t)(i * 8 + (lane >> 3)) * NZ + (lane & 7) * 8);
#pragma unroll
                for (int i = 0; i < 8; ++i) {
                    const int row = i * 8 + (lane >> 3), ch = lane & 7; const u32x4 v = vv[i];
                    LAS bf16_t* tp = (LAS bf16_t*)tsc + (ch * 8) * 72 + row;
                    tp[0 * 72] = (bf16_t)(v.x & 0xffffu); tp[1 * 72] = (bf16_t)(v.x >> 16); tp[2 * 72] = (bf16_t)(v.y & 0xffffu); tp[3 * 72] = (bf16_t)(v.y >> 16);
                    tp[4 * 72] = (bf16_t)(v.z & 0xffffu); tp[5 * 72] = (bf16_t)(v.z >> 16); tp[6 * 72] = (bf16_t)(v.w & 0xffffu); tp[7 * 72] = (bf16_t)(v.w >> 16);
                }
                LDS_WAIT(); asm volatile("" ::: "memory");
#pragma unroll
                for (int i = 0; i < 8; ++i) {
                    const int d = i * 8 + (lane >> 3), ch = lane & 7;
                    const u32x4 v = *(const LAS u32x4*)(tsc + d * 144 + ch * 16);
                    *(GAS u32x4*)(dst + (size_t)d * SEQ + ch * 8) = v;
                }
                LDS_WAIT(); asm volatile("" ::: "memory");
                continue;
            }
            r -= I_VT;
            {
                const int which = r >> 11, rowbase = (r & 2047) * 4, bg = rowbase >> 8, b = bg >> 1, g = bg & 1;
                GAS const float* pos = which ? INP(16) : INP(13);
                GAS bf16_t* dst = (which ? WSB(WS_VBLK) : WSB(WS_KBLK)) + (size_t)rowbase * 2048;
                GAS const bf16_t* src = Zp + (size_t)b * SEQ * NZ + (which ? ZC_VCMP : ZC_KCMP) + g * 64;
                u32x4 vv[4][4];
#pragma unroll
                for (int rr = 0; rr < 4; ++rr) {
                    const int n = (rowbase + rr) & 255;
#pragma unroll
                    for (int i = 0; i < 4; ++i) {
                        const int ch = lane + 64 * i, pp = ch >> 3, dc = ch & 7;
                        vv[rr][i] = (n < 255) ? *(GAS const u32x4*)(src + (size_t)(16 * n + pp) * NZ + dc * 8) : (u32x4){0u, 0u, 0u, 0u};
                    }
                }
#pragma unroll
                for (int i = 0; i < 4; ++i) {
                    const int ch = lane + 64 * i, pp = ch >> 3, dc = ch & 7;
                    const f32x4 p0 = *(GAS const f32x4*)(pos + pp * 64 + dc * 8), p1 = *(GAS const f32x4*)(pos + pp * 64 + dc * 8 + 4);
#pragma unroll
                    for (int rr = 0; rr < 4; ++rr) {
                        const int n = (rowbase + rr) & 255; const u32x4 v = vv[rr][i];
                        u32x4 o = (u32x4){0u, 0u, 0u, 0u};
                        if (n < 255) {
                            o.x = cvt_pk_bf16(bf_lo(v.x) + p0.x, bf_hi(v.x) + p0.y); o.y = cvt_pk_bf16(bf_lo(v.y) + p0.z, bf_hi(v.y) + p0.w);
                            o.z = cvt_pk_bf16(bf_lo(v.z) + p1.x, bf_hi(v.z) + p1.y); o.w = cvt_pk_bf16(bf_lo(v.w) + p1.z, bf_hi(v.w) + p1.w);
                        }
                        *(GAS u32x4*)(dst + (size_t)rr * 2048 + ch * 8) = o;
                    }
                }
            }
        }
#undef UNPK8
    }
    grid.sync();
#if MIXER_MODE >= 2
#pragma unroll 1
    for (int s = 0; s < 2; ++s) {
        pg8::Gemm g{s ? WSB(WS_VBLK) : WSB(WS_KBLK), s ? WSB(WS_CVW1) : WSB(WS_CKW1), 8192, 256, 2048, 2048, 2048}; S.init(8192, 256, G, s ? (bid + G - 32) % G : bid);
        pg8::EpiCmp1 E{s ? WSB(WS_HIDV) : WSB(WS_HIDK)}; pg8::gemm_phase(lds, g, S, E);
    }
    __syncthreads();
#pragma unroll 1
    for (int s = 0; s < 2; ++s) {
        pg8::Gemm g{s ? WSB(WS_HIDV) : WSB(WS_HIDK), s ? WSB(WS_CVW2) : WSB(WS_CKW2), 8192, 256, 256, 256, 256}; S.init(8192, 256, G, s ? (bid + G - 32) % G : bid);
        pg8::EpiCmp2 E{s ? WSB(WS_VCT) : WSB(WS_KC), s}; pg8::gemm_phase(lds, g, S, E);
    }
    grid.sync();
#ifndef REP_ATT
#define REP_ATT 1
#endif
#pragma unroll 1
    for (int rep = 0; rep < REP_ATT; ++rep)
        att::attn_phase(lds, WSB(WS_ACT), WSB(WS_VTS), WSB(WS_VTW), WSB(WS_KC), WSB(WS_VCT), WSB(WS_O), G, bid);
    grid.sync();
#endif
    { pg8::Gemm g{WSB(WS_DELTA), WSB(WS_WA), M, D, 512, 512, 512}; S.init(M, D, G, bid); pg8::EpiGate E{WSB(WS_ACT), WSB(WS_H), ZC_GA, 0}; pg8::gemm_phase(lds, g, S, E); }
#if MIXER_MODE >= 2
    { pg8::Gemm g{WSB(WS_O), WSB(WS_WB), M, D, 512, 512, 512}; S.init(M, D, G, bid); pg8::EpiGate E{WSB(WS_ACT), WSB(WS_H), ZC_GB, 1}; pg8::gemm_phase(lds, g, S, E); }
#endif
    grid.sync();
    { pg8::Gemm g{WSB(WS_H), WSB(WS_WMO), M, D, D, D, D}; S.init(M, D, G, bid); pg8::EpiY E{WSB(WS_DELTA), WSF(WS_ADA) + 5 * D, 1.0f}; pg8::gemm_phase(lds, g, S, E); }
    grid.sync();
#else
    for (size_t i = (size_t)bid * 512 + tid; i < (size_t)M * D / 4; i += (size_t)G * 512) { f32x4 v = ((GAS f32x4*)XOUT)[i]; ((GAS f32x4*)XOUT)[i] = v * ALPHA; }
    grid.sync();
#endif
    ln_rows<true, true, true, false, true, true>(XOUT, WSB(WS_DELTA), WSB(WS_DELTA), WSB(WS_H), INP(22), INP(23), WSF(WS_ADA), 2, INP(2), INP(3), gw, NGW, lane);
    grid.sync();
    { pg8::Gemm g{WSB(WS_H), WSB(WS_W2IN), M, 2 * DFF, D, D, D}; S.init(M, 2 * DFF, G, bid); pg8::EpiSwiglu E{WSB(WS_ACT)}; pg8::gemm_phase(lds, g, S, E); }
    grid.sync();
    { pg8::Gemm g{WSB(WS_ACT), WSB(WS_W2OUT), M, D, DFF, DFF, DFF}; S.init(M, D, G, bid); pg8::EpiY E{WSB(WS_H), WSF(WS_ADA) + 8 * D, 0.5f}; pg8::gemm_phase(lds, g, S, E); }
    grid.sync();
    ln_rows<true, false, true, false, true, false>(WSB(WS_DELTA), WSB(WS_H), XOUT, WSB(WS_H), INP(26), INP(27), WSF(WS_ADA), 0, INP(2), INP(3), gw, NGW, lane);
}

extern "C" void kernel_launch(void* const* d_in, const int* in_sizes, int n_in, void* d_out, int out_size, void* d_ws, size_t ws_size, hipStream_t stream) {
    static int grid = 0;
    if (grid == 0) {
        if (n_in != 28 || out_size != M * D || ws_size < WS_END) { fprintf(stderr, "kernel_launch: unexpected shapes (n_in %d out %d ws %zu)\n", n_in, out_size, ws_size); grid = -1; return; }
        int dev = 0, cus = 0, per_cu = 0;
        hipGetDevice(&dev);
        hipDeviceGetAttribute(&cus, hipDeviceAttributeMultiprocessorCount, dev);
        if (hipFuncSetAttribute((const void*)mega_fwd, hipFuncAttributeMaxDynamicSharedMemorySize, LDS_BYTES) != hipSuccess) { fprintf(stderr, "kernel_launch: hipFuncSetAttribute failed\n"); grid = -1; return; }
        if (hipOccupancyMaxActiveBlocksPerMultiprocessor(&per_cu, (const void*)mega_fwd, 512, LDS_BYTES) != hipSuccess || per_cu < 1) { fprintf(stderr, "kernel_launch: occupancy query says %d\n", per_cu); per_cu = 1; }
        (void)hipGetLastError();
        grid = cus * per_cu;
    }
    if (grid < 0) return;
    Args a{};
    for (int i = 0; i < 28; ++i) a.in[i] = (const float*)d_in[i];
    a.out = (float*)d_out; a.ws = (unsigned char*)d_ws;
    void* args[] = {&a};
    hipError_t e = hipLaunchCooperativeKernel((const void*)mega_fwd, dim3(grid), dim3(512), args, LDS_BYTES, stream);
    if (e != hipSuccess) fprintf(stderr, "cooperative launch failed: %s (grid %d)\n", hipGetErrorString(e), grid);
}
```

```cpp
#include <hip/hip_runtime.h>
#include <hip/hip_cooperative_groups.h>
#include <cstdio>
#include <cstdint>
namespace cg = cooperative_groups;

#define LAS __attribute__((address_space(3)))
#define GAS __attribute__((address_space(1)))
typedef unsigned short bf16_t;
typedef short bf16x8 __attribute__((ext_vector_type(8)));
typedef float f32x4 __attribute__((ext_vector_type(4)));
typedef float f32x16 __attribute__((ext_vector_type(16)));
typedef unsigned u32x4 __attribute__((ext_vector_type(4)));
typedef unsigned u32x2 __attribute__((ext_vector_type(2)));

#ifndef MIXER_MODE
#define MIXER_MODE 2
#endif

constexpr int D = 1024, NBATCH = 16, SEQ = 4096, M = NBATCH * SEQ, DFF = 2816, NZ = 4096, NADA = 9 * D;
constexpr float ALPHA = 1.189207115002721f;
constexpr float LN_EPS = 1e-5f;
constexpr float LOG2E = 1.4426950408889634f;
constexpr int ZC_Q = 512, ZC_KCMP = 1024, ZC_VCMP = 1152, ZC_KSLC = 1280, ZC_VSLC = 1408, ZC_KWIN = 1536, ZC_VWIN = 1664, ZC_GNSA = 1792, ZC_GA = 2048, ZC_GB = 3072;

constexpr size_t MiB = 1u << 20;
constexpr size_t WS_ADA = 1 * MiB;
constexpr size_t WS_W1IN = 2 * MiB;
constexpr size_t WS_W1OUT = 13 * MiB;
constexpr size_t WS_W2IN = 19 * MiB;
constexpr size_t WS_W2OUT = 30 * MiB;
constexpr size_t WS_WMIX = 36 * MiB;
constexpr size_t WS_WA = 44 * MiB;
constexpr size_t WS_WB = 45 * MiB;
constexpr size_t WS_WMO = 46 * MiB;
constexpr size_t WS_CKW1 = 48 * MiB;
constexpr size_t WS_CVW1 = 49 * MiB;
constexpr size_t WS_CKW2 = 50 * MiB;
constexpr size_t WS_CVW2 = 50 * MiB + 512 * 1024;
constexpr size_t WS_KC = 51 * MiB;
constexpr size_t WS_VCT = 52 * MiB;
constexpr size_t WS_HIDK = 53 * MiB;
constexpr size_t WS_HIDV = 57 * MiB;
constexpr size_t WS_VTS = 64 * MiB;
constexpr size_t WS_VTW = 80 * MiB;
constexpr size_t WS_H = 96 * MiB;
constexpr size_t WS_DELTA = 224 * MiB;
constexpr size_t WS_O = 288 * MiB;
constexpr size_t WS_ACT = 352 * MiB;
constexpr size_t WS_KBLK = 864 * MiB;
constexpr size_t WS_VBLK = 896 * MiB;
constexpr size_t WS_END = 928 * MiB;

constexpr int LDS_BYTES = 147456;

__device__ __forceinline__ unsigned cvt_pk_bf16(float lo, float hi) { unsigned r; asm("v_cvt_pk_bf16_f32 %0, %1, %2" : "=v"(r) : "v"(lo), "v"(hi)); return r; }
__device__ __forceinline__ float bf_lo(unsigned u) { return __uint_as_float(u << 16); }
__device__ __forceinline__ float bf_hi(unsigned u) { return __uint_as_float(u & 0xffff0000u); }
__device__ __forceinline__ float fast_rcp(float x) { return __builtin_amdgcn_rcpf(x); }
__device__ __forceinline__ float fast_exp2(float x) { return __builtin_amdgcn_exp2f(x); }
__device__ __forceinline__ float sigmoidf_(float x) { return fast_rcp(1.0f + fast_exp2(-x * LOG2E)); }
__device__ __forceinline__ float siluf_(float x) { return x * sigmoidf_(x); }
__device__ __forceinline__ float gelu_tanh(float x) { const float u = 0.7978845608028654f * (x + 0.044715f * x * x * x); const float e = fast_exp2(2.0f * LOG2E * u); const float th = 1.0f - 2.0f * fast_rcp(e + 1.0f); return 0.5f * x * (1.0f + th); }
#define LDS_WAIT() asm volatile("s_waitcnt lgkmcnt(0)" ::: "memory")

namespace pg8 {
constexpr int BM = 256, BK = 64, HALF = 128, HTB = HALF * BK * 2, STAGE_BYTES = 8 * HTB, NXCD = 8, WGM = 8;
__host__ __device__ __forceinline__ int lds_byte(int r, int c) { const int st = (r >> 4) * 2 + (c >> 5), rr = r & 15, cc = c & 31, ob = rr * 64 + cc * 2; return st * 1024 + (ob ^ (((ob >> 9) & 1) << 5)); }
__host__ __device__ __forceinline__ void stage_rc(int b, int& R, int& C) { const int st = b / 1024, sb = b % 1024, swz = sb ^ (((sb >> 9) & 1) << 5); R = (st >> 1) * 16 + swz / 64; C = (st & 1) * 32 + (swz % 64) / 2; }
__host__ __device__ __forceinline__ int perm32(int rho) { const int n = rho >> 4, i = rho & 15; return 8 * (i >> 2) + 4 * n + (i & 3); }

struct Unit { int pm, pn; };
struct Gemm { GAS const bf16_t* A; GAS const bf16_t* Bt; int M, N, K, lda, ldb; };

struct StaticOrder {
    int nM, nN, nwg, G, c;
    __device__ void init(int M_, int N_, int G_, int c_) { nM = M_ / BM; nN = N_ / BM; nwg = nM * nN; G = G_; c = c_; }
    __device__ bool next(int i, Unit& u) const {
        const long L = (long)i * G + c; if (L >= nwg) return false;
        int wgid = (int)L; { const int q = nwg / NXCD, r = nwg % NXCD, xcd = wgid % NXCD, off = wgid / NXCD; wgid = (xcd < r ? xcd * (q + 1) : r * (q + 1) + (xcd - r) * q) + off; }
        const int nig = WGM * nN, gid = wgid / nig, fm = gid * WGM, gsz = (nM - fm) < WGM ? (nM - fm) : WGM;
        u.pm = fm + ((wgid % nig) % gsz); u.pn = (wgid % nig) / gsz; return true;
    }
};

template <class Epi>
__device__ __forceinline__ void gemm_phase(LAS unsigned char* lds, const Gemm g, const StaticOrder& S, const Epi& E) {
    int tid_ = threadIdx.x; asm volatile("" : "+v"(tid_));
    const int tid = tid_, wid = __builtin_amdgcn_readfirstlane(tid >> 6), lane = tid & 63, wr = wid >> 2, wc = wid & 3, fr = lane & 15, fq = lane >> 4;
    const int K = g.K, nt = K / BK;
    unsigned voffA[2], voffB[2];
#pragma unroll
    for (int i = 0; i < 2; ++i) { int R, C; stage_rc(tid * 16 + i * 8192, R, C); const int Rb = Epi::PERM ? ((R & ~31) + perm32(R & 31)) : R;
        voffA[i] = (unsigned)(R * g.lda + C) * 2u; voffB[i] = (unsigned)(Rb * g.ldb + C) * 2u; }
    const size_t kstep = (size_t)(BK * 2);
    const size_t hstepA = (size_t)HALF * g.lda * 2, hstepB = (size_t)HALF * g.ldb * 2;
    const size_t tstepA = 2 * hstepA, tstepB = 2 * hstepB;
    const unsigned ldsw = (unsigned)wid * 1024u;
    const int aoff = lds_byte(wr * 64 + fr, fq * 8), boff = lds_byte(wc * 32 + fr, fq * 8);
#define PG8_SA(b, h) (((b) * 2 + (h)) * HTB)
#define PG8_SB(b, h) ((4 + (b) * 2 + (h)) * HTB)
#define PG8_STAGE(bufoff, gbase, voff) do { _Pragma("unroll") for (int _i = 0; _i < 2; ++_i) \
        __builtin_amdgcn_global_load_lds((GAS const unsigned*)((gbase) + (voff)[_i]), (LAS unsigned*)(lds + (bufoff) + ldsw + _i * 8192), 16, 0, 0); } while (0)
#define PG8_LDA(dst, b, h) do { _Pragma("unroll") for (int m = 0; m < 4; ++m) _Pragma("unroll") for (int k = 0; k < 2; ++k) dst[m][k] = *(const LAS bf16x8*)(lds + PG8_SA(b, h) + aoff + m * 2048 + k * 1024); } while (0)
#define PG8_LDB(dst, b, h) do { _Pragma("unroll") for (int n = 0; n < 2; ++n) _Pragma("unroll") for (int k = 0; k < 2; ++k) dst[n][k] = *(const LAS bf16x8*)(lds + PG8_SB(b, h) + boff + n * 2048 + k * 1024); } while (0)
#define PG8_MMA(ai, bj, At, Bt) do { __builtin_amdgcn_s_setprio(1); _Pragma("unroll") for (int m = 0; m < 4; ++m) _Pragma("unroll") for (int n = 0; n < 2; ++n) _Pragma("unroll") for (int k = 0; k < 2; ++k) \
        acc[ai][bj][m][n] = __builtin_amdgcn_mfma_f32_16x16x32_bf16(Bt[n][k], At[m][k], acc[ai][bj][m][n], 0, 0, 0); __builtin_amdgcn_s_setprio(0); } while (0)
#define PG8_WAIT_V(n) asm volatile("s_waitcnt vmcnt(" #n ")" ::: "memory")
#define PG8_WAIT_L(n) asm volatile("s_waitcnt lgkmcnt(" #n ")" ::: "memory")
#define PG8_BAR __builtin_amdgcn_s_barrier()
#define PG8_SCHED __builtin_amdgcn_sched_barrier(0)
    Unit cur, nxt; int ui = 0;
    if (!S.next(0, cur)) return;
    f32x4 acc[2][2][4][2];
#pragma unroll
    for (int a = 0; a < 2; ++a)
#pragma unroll
        for (int b = 0; b < 2; ++b)
#pragma unroll
            for (int m = 0; m < 4; ++m)
#pragma unroll
                for (int n = 0; n < 2; ++n) acc[a][b][m][n] = (f32x4){0.f, 0.f, 0.f, 0.f};
    bf16x8 At[4][2], B0[2][2], B1[2][2];
    GAS const char* cA = (GAS const char*)g.A + (size_t)cur.pm * tstepA; GAS const char* cB = (GAS const char*)g.Bt + (size_t)cur.pn * tstepB;
    PG8_STAGE(PG8_SB(0, 0), cB, voffB); PG8_STAGE(PG8_SB(0, 1), cB + hstepB, voffB); PG8_STAGE(PG8_SA(0, 0), cA, voffA); PG8_STAGE(PG8_SA(0, 1), cA + hstepA, voffA);
    if (wr == 1) PG8_BAR;
    PG8_WAIT_V(2); PG8_BAR;
    PG8_STAGE(PG8_SB(1, 0), cB + kstep, voffB); PG8_STAGE(PG8_SA(1, 0), cA + kstep, voffA); PG8_STAGE(PG8_SB(1, 1), cB + hstepB + kstep, voffB);
    PG8_WAIT_V(6); PG8_BAR;
    for (;;) {
        const bool has_next = S.next(ui + 1, nxt);
        GAS const char* nA = has_next ? (GAS const char*)g.A + (size_t)nxt.pm * tstepA : cA; GAS const char* nB = has_next ? (GAS const char*)g.Bt + (size_t)nxt.pn * tstepB : cB;
        for (int t = 0; t < nt; t += 2) {
            const bool last = (t == nt - 2);
            GAS const char* a1 = cA + (size_t)(t + 1) * kstep;
            GAS const char* a2 = last ? nA : cA + (size_t)(t + 2) * kstep; GAS const char* b2 = last ? nB : cB + (size_t)(t + 2) * kstep;
            GAS const char* a3 = a2 + kstep; GAS const char* b3 = b2 + kstep;
            PG8_LDB(B0, 0, 0); PG8_LDB(B1, 0, 1); PG8_SCHED; PG8_LDA(At, 0, 0); PG8_STAGE(PG8_SA(1, 1), a1 + hstepA, voffA);
            PG8_WAIT_V(8); PG8_WAIT_L(0); PG8_BAR; PG8_MMA(0, 0, At, B0); PG8_MMA(0, 1, At, B1); PG8_BAR; PG8_SCHED;
            PG8_LDA(At, 0, 1); PG8_STAGE(PG8_SB(0, 0), b2, voffB); PG8_STAGE(PG8_SB(0, 1), b2 + hstepB, voffB); PG8_STAGE(PG8_SA(0, 0), a2, voffA);
            PG8_WAIT_V(8); PG8_WAIT_L(0); PG8_BAR; PG8_MMA(1, 0, At, B0); PG8_MMA(1, 1, At, B1); PG8_BAR; PG8_SCHED;
            PG8_LDB(B0, 1, 0); PG8_LDB(B1, 1, 1); PG8_SCHED; PG8_LDA(At, 1, 0); PG8_STAGE(PG8_SA(0, 1), a2 + hstepA, voffA);
            PG8_WAIT_V(8); PG8_WAIT_L(0); PG8_BAR; PG8_MMA(0, 0, At, B0); PG8_MMA(0, 1, At, B1); PG8_BAR; PG8_SCHED;
            PG8_LDA(At, 1, 1); PG8_STAGE(PG8_SB(1, 0), b3, voffB); PG8_STAGE(PG8_SB(1, 1), b3 + hstepB, voffB); PG8_STAGE(PG8_SA(1, 0), a3, voffA);
            PG8_WAIT_V(8); PG8_WAIT_L(0); PG8_BAR; PG8_MMA(1, 0, At, B0); PG8_MMA(1, 1, At, B1); PG8_BAR; PG8_SCHED;
        }
        if (wr == 0) PG8_BAR;
        E(acc, cur, wr, wc, fr, fq);
        if (!has_next) break;
#pragma unroll
        for (int a = 0; a < 2; ++a)
#pragma unroll
            for (int b = 0; b < 2; ++b)
#pragma unroll
                for (int m = 0; m < 4; ++m)
#pragma unroll
                    for (int n = 0; n < 2; ++n) acc[a][b][m][n] = (f32x4){0.f, 0.f, 0.f, 0.f};
        cur = nxt; cA = nA; cB = nB; ++ui;
        if (wr == 1) PG8_BAR;
    }
    PG8_WAIT_V(0);
    PG8_BAR;
#undef PG8_SA
#undef PG8_SB
#undef PG8_STAGE
#undef PG8_LDA
#undef PG8_LDB
#undef PG8_MMA
#undef PG8_WAIT_V
#undef PG8_WAIT_L
#undef PG8_BAR
#undef PG8_SCHED
}

typedef const f32x4 (&AccRef)[2][2][4][2];

struct EpiSwiglu {
    static constexpr bool PERM = true;
    GAS bf16_t* O;
    __device__ __forceinline__ void operator()(AccRef acc, const Unit& u, int wr, int wc, int fr, int fq) const {
        const int row0 = u.pm * BM + wr * 64 + fr, col0 = u.pn * HALF + wc * 32 + 8 * fq;
#pragma unroll
        for (int ai = 0; ai < 2; ++ai)
#pragma unroll
            for (int m = 0; m < 4; ++m) {
                GAS bf16_t* rowp = O + (size_t)(row0 + ai * HALF + m * 16) * DFF + col0;
                const f32x4 g0 = acc[ai][0][m][0], g1 = acc[ai][0][m][1], u0 = acc[ai][1][m][0], u1 = acc[ai][1][m][1];
                u32x4 w;
                w.x = cvt_pk_bf16(siluf_(g0[0]) * u0[0], siluf_(g0[1]) * u0[1]); w.y = cvt_pk_bf16(siluf_(g0[2]) * u0[2], siluf_(g0[3]) * u0[3]);
                w.z = cvt_pk_bf16(siluf_(g1[0]) * u1[0], siluf_(g1[1]) * u1[1]); w.w = cvt_pk_bf16(siluf_(g1[2]) * u1[2], siluf_(g1[3]) * u1[3]);
                *(GAS u32x4*)rowp = w;
            }
    }
};

struct EpiY {
    static constexpr bool PERM = true;
    GAS bf16_t* Y; GAS const float* gate; float coef;
    __device__ __forceinline__ void operator()(AccRef acc, const Unit& u, int wr, int wc, int fr, int fq) const {
        const int row0 = u.pm * BM + wr * 64 + fr, col0 = u.pn * BM + wc * 32 + 8 * fq;
        GAS const float* gp = gate + (size_t)(u.pm >> 4) * NADA + col0;
        f32x4 gv[2][2];
#pragma unroll
        for (int bj = 0; bj < 2; ++bj)
#pragma unroll
            for (int n = 0; n < 2; ++n) gv[bj][n] = *(GAS const f32x4*)(gp + bj * HALF + n * 4) * coef;
#pragma unroll
        for (int ai = 0; ai < 2; ++ai)
#pragma unroll
            for (int m = 0; m < 4; ++m) {
                GAS bf16_t* rowp = Y + (size_t)(row0 + ai * HALF + m * 16) * D + col0;
#pragma unroll
                for (int bj = 0; bj < 2; ++bj) {
                    const f32x4 v0 = acc[ai][bj][m][0] * gv[bj][0], v1 = acc[ai][bj][m][1] * gv[bj][1];
                    u32x4 w; w.x = cvt_pk_bf16(v0[0], v0[1]); w.y = cvt_pk_bf16(v0[2], v0[3]); w.z = cvt_pk_bf16(v1[0], v1[1]); w.w = cvt_pk_bf16(v1[2], v1[3]);
                    *(GAS u32x4*)(rowp + bj * HALF) = w;
                }
            }
    }
};

struct EpiZ {
    static constexpr bool PERM = true;
    GAS bf16_t* Z;
    __device__ __forceinline__ void operator()(AccRef acc, const Unit& u, int wr, int wc, int fr, int fq) const {
        const int row0 = u.pm * BM + wr * 64 + fr, col0 = u.pn * BM + wc * 32 + 8 * fq;
        const bool sg = u.pn >= 7;
#pragma unroll
        for (int ai = 0; ai < 2; ++ai)
#pragma unroll
            for (int m = 0; m < 4; ++m) {
                GAS bf16_t* rowp = Z + (size_t)(row0 + ai * HALF + m * 16) * NZ + col0;
#pragma unroll
                for (int bj = 0; bj < 2; ++bj) {
                    f32x4 v0 = acc[ai][bj][m][0], v1 = acc[ai][bj][m][1];
                    if (sg) {
#pragma unroll
                        for (int j = 0; j < 4; ++j) { v0[j] = sigmoidf_(v0[j]); v1[j] = sigmoidf_(v1[j]); }
                    }
                    u32x4 w; w.x = cvt_pk_bf16(v0[0], v0[1]); w.y = cvt_pk_bf16(v0[2], v0[3]); w.z = cvt_pk_bf16(v1[0], v1[1]); w.w = cvt_pk_bf16(v1[2], v1[3]);
                    *(GAS u32x4*)(rowp + bj * HALF) = w;
                }
            }
    }
};

struct EpiGate {
    static constexpr bool PERM = true;
    GAS const bf16_t* Z; GAS bf16_t* MX; int goff; int add;
    __device__ __forceinline__ void operator()(AccRef acc, const Unit& u, int wr, int wc, int fr, int fq) const {
        const int row0 = u.pm * BM + wr * 64 + fr, col0 = u.pn * BM + wc * 32 + 8 * fq;
#pragma unroll
        for (int ai = 0; ai < 2; ++ai)
#pragma unroll
            for (int m = 0; m < 4; ++m) {
                const size_t row = (size_t)(row0 + ai * HALF + m * 16);
#pragma unroll
                for (int bj = 0; bj < 2; ++bj) {
                    const u32x4 gz = *(GAS const u32x4*)(Z + row * NZ + goff + col0 + bj * HALF);
                    GAS bf16_t* op = MX + row * D + col0 + bj * HALF;
                    const f32x4 v0 = acc[ai][bj][m][0], v1 = acc[ai][bj][m][1];
                    float r[8];
                    r[0] = bf_lo(gz.x) * v0[0]; r[1] = bf_hi(gz.x) * v0[1]; r[2] = bf_lo(gz.y) * v0[2]; r[3] = bf_hi(gz.y) * v0[3];
                    r[4] = bf_lo(gz.z) * v1[0]; r[5] = bf_hi(gz.z) * v1[1]; r[6] = bf_lo(gz.w) * v1[2]; r[7] = bf_hi(gz.w) * v1[3];
                    if (add) { const u32x4 pv = *(GAS const u32x4*)op;
                        r[0] += bf_lo(pv.x); r[1] += bf_hi(pv.x); r[2] += bf_lo(pv.y); r[3] += bf_hi(pv.y); r[4] += bf_lo(pv.z); r[5] += bf_hi(pv.z); r[6] += bf_lo(pv.w); r[7] += bf_hi(pv.w); }
                    u32x4 w; w.x = cvt_pk_bf16(r[0], r[1]); w.y = cvt_pk_bf16(r[2], r[3]); w.z = cvt_pk_bf16(r[4], r[5]); w.w = cvt_pk_bf16(r[6], r[7]);
                    *(GAS u32x4*)op = w;
                }
            }
    }
};

struct EpiCmp1 {
    static constexpr bool PERM = true;
    GAS bf16_t* Hd;
    __device__ __forceinline__ void operator()(AccRef acc, const Unit& u, int wr, int wc, int fr, int fq) const {
        const int row0 = u.pm * BM + wr * 64 + fr, col0 = wc * 32 + 8 * fq;
#pragma unroll
        for (int ai = 0; ai < 2; ++ai)
#pragma unroll
            for (int m = 0; m < 4; ++m) {
                GAS bf16_t* rowp = Hd + (size_t)(row0 + ai * HALF + m * 16) * 256 + col0;
#pragma unroll
                for (int bj = 0; bj < 2; ++bj) {
                    const f32x4 v0 = acc[ai][bj][m][0], v1 = acc[ai][bj][m][1];
                    u32x4 w; w.x = cvt_pk_bf16(gelu_tanh(v0[0]), gelu_tanh(v0[1])); w.y = cvt_pk_bf16(gelu_tanh(v0[2]), gelu_tanh(v0[3]));
                    w.z = cvt_pk_bf16(gelu_tanh(v1[0]), gelu_tanh(v1[1])); w.w = cvt_pk_bf16(gelu_tanh(v1[2]), gelu_tanh(v1[3]));
                    *(GAS u32x4*)(rowp + bj * HALF) = w;
                }
            }
    }
};

struct EpiCmp2 {
    static constexpr bool PERM = true;
    GAS bf16_t* out; int tr;
    __device__ __forceinline__ void operator()(AccRef acc, const Unit& u, int wr, int wc, int fr, int fq) const {
        if (wc >= 2) return;
        const int row0 = u.pm * BM + wr * 64 + fr, col0 = wc * 32 + 8 * fq;
#pragma unroll
        for (int ai = 0; ai < 2; ++ai)
#pragma unroll
            for (int m = 0; m < 4; ++m) {
                const int row = row0 + ai * HALF + m * 16;
                const f32x4 v0 = acc[ai][0][m][0], v1 = acc[ai][0][m][1];
                u32x4 w; w.x = cvt_pk_bf16(v0[0], v0[1]); w.y = cvt_pk_bf16(v0[2], v0[3]); w.z = cvt_pk_bf16(v1[0], v1[1]); w.w = cvt_pk_bf16(v1[2], v1[3]);
                if (!tr) { *(GAS u32x4*)(out + (size_t)row * 64 + col0) = w; }
                else {
                    GAS bf16_t* base = out + ((size_t)(row >> 8) * 64 + col0) * 256 + (row & 255);
                    base[0 * 256] = (bf16_t)(w.x & 0xffffu); base[1 * 256] = (bf16_t)(w.x >> 16); base[2 * 256] = (bf16_t)(w.y & 0xffffu); base[3 * 256] = (bf16_t)(w.y >> 16);
                    base[4 * 256] = (bf16_t)(w.z & 0xffffu); base[5 * 256] = (bf16_t)(w.z >> 16); base[6 * 256] = (bf16_t)(w.w & 0xffffu); base[7 * 256] = (bf16_t)(w.w >> 16);
                }
            }
    }
};
}

__device__ __forceinline__ float wave_sum(float v) {
#pragma unroll
    for (int o = 1; o < 64; o <<= 1) v += __shfl_xor(v, o);
    return v;
}

__device__ __forceinline__ void tr_item(GAS const float* __restrict__ W, int N, GAS bf16_t* WT, int ldd, int map, LAS float* scr, int item, int nblk, int lane) {
    const int kb = item / nblk, nb = item % nblk, k0 = 64 * kb, n0 = 32 * nb;
    const int nd = n0 + (lane & 31);
    int sc;
    if (map == 0) sc = nd;
    else if (map == 1) { const int t = nd >> 8, r = nd & 255; sc = r < 128 ? 128 * t + r : DFF + 128 * t + (r - 128); }
    else if (map == 2) sc = nd < 1816 ? nd : (nd < 2048 ? -1 : nd - 232);
    else sc = nd < 64 ? nd : -1;
    const int scl = sc >= 0 ? sc : 0;
    float wv[32];
#pragma unroll
    for (int i = 0; i < 32; ++i) wv[i] = W[(size_t)(k0 + 2 * i + (lane >> 5)) * N + scl];
#pragma unroll
    for (int i = 0; i < 32; ++i) { const int kk = 2 * i + (lane >> 5); scr[kk * 33 + (lane & 31)] = sc >= 0 ? wv[i] : 0.f; }
    LDS_WAIT(); asm volatile("" ::: "memory");
    const int c = lane & 7;
#pragma unroll
    for (int j = 0; j < 4; ++j) { const int n = (lane >> 3) + 8 * j; const LAS float* s = scr + (8 * c) * 33 + n;
        u32x4 o; o.x = cvt_pk_bf16(s[0 * 33], s[1 * 33]); o.y = cvt_pk_bf16(s[2 * 33], s[3 * 33]); o.z = cvt_pk_bf16(s[4 * 33], s[5 * 33]); o.w = cvt_pk_bf16(s[6 * 33], s[7 * 33]);
        *(GAS u32x4*)(WT + (size_t)(n0 + n) * ldd + k0 + 8 * c) = o; }
    LDS_WAIT(); asm volatile("" ::: "memory");
}

template <bool WRITE_X, bool WRITE_H, bool ADD_Y, bool PRE_LN, bool SRC_BF16, bool X_BF16>
__device__ __forceinline__ void ln_rows(GAS const void* srcv, GAS const bf16_t* Y, GAS void* Xv, GAS bf16_t* H, GAS const float* __restrict__ lg, GAS const float* __restrict__ lb, GAS const float* ada, int modi,
                                        GAS const float* __restrict__ pg, GAS const float* __restrict__ pb, int gw, int NGW, int lane) {
    for (int row0 = 2 * gw; row0 < M; row0 += 2 * NGW) {
        f32x4 v[2][4]; u32x2 yv[2][4];
#pragma unroll
        for (int rr = 0; rr < 2; ++rr) {
            const int row = row0 + rr;
#pragma unroll
            for (int j = 0; j < 4; ++j) {
                if (SRC_BF16) { const u32x2 xb = ((GAS const u32x2*)((GAS const bf16_t*)srcv + (size_t)row * D) + lane)[64 * j]; v[rr][j] = (f32x4){bf_lo(xb.x), bf_hi(xb.x), bf_lo(xb.y), bf_hi(xb.y)}; }
                else v[rr][j] = ((GAS const f32x4*)((GAS const float*)srcv + (size_t)row * D) + lane)[64 * j];
                if (ADD_Y) yv[rr][j] = ((GAS const u32x2*)(Y + (size_t)row * D) + lane)[64 * j];
            }
        }
#pragma unroll
        for (int rr = 0; rr < 2; ++rr) {
            const int row = row0 + rr;
            if (PRE_LN) {
                float s = 0.f;
#pragma unroll
                for (int j = 0; j < 4; ++j) s += (v[rr][j].x + v[rr][j].y) + (v[rr][j].z + v[rr][j].w);
                const float mean = wave_sum(s) * (1.f / D); float s2 = 0.f;
#pragma unroll
                for (int j = 0; j < 4; ++j) { v[rr][j] = v[rr][j] - mean; s2 += (v[rr][j].x * v[rr][j].x + v[rr][j].y * v[rr][j].y) + (v[rr][j].z * v[rr][j].z + v[rr][j].w * v[rr][j].w); }
                const float rstd = 1.f / sqrtf(wave_sum(s2) * (1.f / D) + LN_EPS);
#pragma unroll
                for (int j = 0; j < 4; ++j) { const int col = 4 * lane + 256 * j; v[rr][j] = v[rr][j] * rstd * *(GAS const f32x4*)(pg + col) + *(GAS const f32x4*)(pb + col); }
            }
            float s = 0.f;
#pragma unroll
            for (int j = 0; j < 4; ++j) {
                if (ADD_Y) { const u32x2 y = yv[rr][j]; v[rr][j] = v[rr][j] * ALPHA + (f32x4){bf_lo(y.x), bf_hi(y.x), bf_lo(y.y), bf_hi(y.y)}; }
                s += (v[rr][j].x + v[rr][j].y) + (v[rr][j].z + v[rr][j].w);
            }
            const float mean = wave_sum(s) * (1.f / D); float s2 = 0.f;
#pragma unroll
            for (int j = 0; j < 4; ++j) { v[rr][j] = v[rr][j] - mean; s2 += (v[rr][j].x * v[rr][j].x + v[rr][j].y * v[rr][j].y) + (v[rr][j].z * v[rr][j].z + v[rr][j].w * v[rr][j].w); }
            const float rstd = 1.f / sqrtf(wave_sum(s2) * (1.f / D) + LN_EPS);
            GAS const float* ab = ada + (size_t)(row >> 12) * NADA + (size_t)modi * 3 * D;
            GAS u32x2* ho = (GAS u32x2*)(H + (size_t)row * D) + lane;
#pragma unroll
            for (int j = 0; j < 4; ++j) {
                const int col = 4 * lane + 256 * j;
                const f32x4 gg = *(GAS const f32x4*)(lg + col), bb = *(GAS const f32x4*)(lb + col);
                const f32x4 y = v[rr][j] * rstd * gg + bb;
                if (WRITE_X) {
                    if (X_BF16) { u32x2 w; w.x = cvt_pk_bf16(y.x, y.y); w.y = cvt_pk_bf16(y.z, y.w); ((GAS u32x2*)((GAS bf16_t*)Xv + (size_t)row * D) + lane)[64 * j] = w; }
                    else ((GAS f32x4*)((GAS float*)Xv + (size_t)row * D) + lane)[64 * j] = y;
                }
                if (WRITE_H) {
                    const f32x4 sh = *(GAS const f32x4*)(ab + col), sc = *(GAS const f32x4*)(ab + D + col);
                    const f32x4 h = y * (sc + 1.0f) + sh;
                    u32x2 w; w.x = cvt_pk_bf16(h.x, h.y); w.y = cvt_pk_bf16(h.z, h.w);
                    ho[64 * j] = w;
                }
            }
        }
    }
}

namespace att {
constexpr int SLOT_BYTES = 16384, NSLOT = 3;
constexpr int OFF_IMP = NSLOT * SLOT_BYTES;
constexpr int IMP_PITCH = 65;
constexpr int OFF_SCORE = OFF_IMP + 4 * 64 * IMP_PITCH * 4;
constexpr int OFF_SEL = OFF_SCORE + 64 * IMP_PITCH * 4;
constexpr int OFF_UN = OFF_SEL + 512;
constexpr int OFF_LIST = OFF_UN + 16;
constexpr float NEGV = -1e30f;
constexpr float C2 = 0.125f * LOG2E;

struct Src { GAS const bf16_t* k; GAS const bf16_t* v; int kpitch, vpitch; };

template <int MODE, bool INTERIOR>
__device__ __forceinline__ void tile_compute(const LAS unsigned char* Kb, const LAS unsigned char* Vb, const bf16x8 (&qf)[4], f32x16 (&o)[2], float& m, float& l, float inv_l,
                                             int tile, int t, float slope2, bool selbit, int qb, int ql, int hh, float (&prim)[8], float& carry) {
    const int swz4 = ((ql >> 1) & 7) << 4;
    bf16x8 kf[4][2];
#pragma unroll
    for (int ds = 0; ds < 4; ++ds) {
        kf[ds][0] = *(const LAS bf16x8*)(Kb + ql * 128 + (((ds * 2 + hh) << 4) ^ swz4));
        kf[ds][1] = *(const LAS bf16x8*)(Kb + (32 + ql) * 128 + (((ds * 2 + hh) << 4) ^ swz4));
    }
    __builtin_amdgcn_sched_barrier(0);
    f32x16 s[2];
    if (INTERIOR) {
        const float slopeC = slope2 * (1.0f / C2) * (MODE <= 1 ? 16.f : 1.f);
        float b0C = (MODE <= 1) ? slope2 * (1.0f / C2) * (float)(16 * (tile * 64 + 4 * hh) + 31 - t) : slopeC * (float)(tile * 64 + 4 * hh - t);
        if (MODE == 2 && !selbit) b0C = NEGV;
#pragma unroll
        for (int sub = 0; sub < 2; ++sub)
#pragma unroll
            for (int i = 0; i < 16; ++i) s[sub][i] = __builtin_fmaf(slopeC, (float)(sub * 32 + (i & 3) + 8 * (i >> 2)), b0C);
    } else {
#pragma unroll
        for (int i = 0; i < 16; ++i) { s[0][i] = 0.f; s[1][i] = 0.f; }
    }
#pragma unroll
    for (int ds = 0; ds < 4; ++ds) {
        s[0] = __builtin_amdgcn_mfma_f32_32x32x16_bf16(kf[ds][0], qf[ds], s[0], 0, 0, 0);
        s[1] = __builtin_amdgcn_mfma_f32_32x32x16_bf16(kf[ds][1], qf[ds], s[1], 0, 0, 0);
    }
    constexpr bool VPRE = INTERIOR && MODE >= 2;
    u32x2 vlo[4][2], vhi[4][2];
    if (VPRE) {
#pragma unroll
        for (int ks = 0; ks < 4; ++ks)
#pragma unroll
            for (int dsub = 0; dsub < 2; ++dsub) {
                const LAS unsigned char* vrow = Vb + (dsub * 32 + ql) * 128 + hh * 8;
                vlo[ks][dsub] = *(const LAS u32x2*)(vrow + (((ks * 2) << 4) ^ swz4)); vhi[ks][dsub] = *(const LAS u32x2*)(vrow + (((ks * 2 + 1) << 4) ^ swz4));
            }
        __builtin_amdgcn_sched_barrier(0);
    }
    float mx = NEGV;
    if (INTERIOR) {
#pragma unroll
        for (int sub = 0; sub < 2; ++sub)
#pragma unroll
            for (int i = 0; i < 16; ++i) { const float sv = s[sub][i] * C2; s[sub][i] = sv; mx = fmaxf(mx, sv); }
    } else {
        __builtin_amdgcn_sched_barrier(0);
        const float base = (MODE <= 1) ? (float)(t - 31 - 16 * (tile * 64 + 4 * hh)) : (float)(t - tile * 64 - 4 * hh);
        const float step = (MODE <= 1) ? 16.f : 1.f;
        const float nslope = -slope2;
#pragma unroll
        for (int sub = 0; sub < 2; ++sub)
#pragma unroll
            for (int i = 0; i < 16; ++i) {
                const float cpos = (float)(sub * 32 + (i & 3) + 8 * (i >> 2));
                const float dist = base - step * cpos;
                bool valid = dist >= 0.f;
                if (MODE == 2) valid = valid && selbit;
                if (MODE == 3) valid = valid && dist < 512.f;
                const float sv = valid ? __builtin_fmaf(s[sub][i], C2, nslope * dist) : NEGV;
                s[sub][i] = sv; mx = fmaxf(mx, sv);
            }
    }
    if (MODE != 1) {
        mx = fmaxf(mx, __shfl_xor(mx, 32));
        const float mn = fmaxf(m, mx);
        float rs = 0.f;
#pragma unroll
        for (int sub = 0; sub < 2; ++sub)
#pragma unroll
            for (int i = 0; i < 16; ++i) { const float sv = s[sub][i]; const float p = INTERIOR ? fast_exp2(sv - mn) : (sv > -1e29f ? fast_exp2(sv - mn) : 0.f); s[sub][i] = p; rs += p; }
        rs += __shfl_xor(rs, 32);
        if (__builtin_amdgcn_ballot_w64(mn > m) != 0ull) {
            const float alpha = fast_exp2(m - mn);
            l *= alpha;
            if (MODE != 0) {
#pragma unroll
                for (int i = 0; i < 16; ++i) { o[0][i] *= alpha; o[1][i] *= alpha; }
            }
        }
        l += rs; m = mn;
    } else {
#pragma unroll
        for (int sub = 0; sub < 2; ++sub)
#pragma unroll
            for (int i = 0; i < 16; ++i) { const float sv = s[sub][i]; s[sub][i] = (INTERIOR || sv > -1e29f) ? fast_exp2(sv - m) * inv_l : 0.f; }
        float sp[8];
#pragma unroll
        for (int k = 0; k < 8; ++k) { const int sub = k >> 2, i0 = (k & 3) * 4; prim[k] = (s[sub][i0] + s[sub][i0 + 1]) + (s[sub][i0 + 2] + s[sub][i0 + 3]); sp[k] = s[sub][i0 + 3]; }
        float x[8];
#pragma unroll
        for (int k = 0; k < 8; ++k) x[k] = __shfl_xor(sp[k], 32);
#pragma unroll
        for (int k = 0; k < 8; ++k) { const float fromlow = (k > 0) ? x[k > 0 ? k - 1 : 0] : carry; prim[k] += hh ? x[k] : fromlow; }
        carry = x[7];
    }
    if (MODE != 0) {
#pragma unroll
        for (int ks = 0; ks < 4; ++ks) {
            const int sub = ks >> 1, i0 = (ks & 1) * 8;
            union { u32x4 u; bf16x8 b; } pk;
            pk.u.x = cvt_pk_bf16(s[sub][i0 + 0], s[sub][i0 + 1]); pk.u.y = cvt_pk_bf16(s[sub][i0 + 2], s[sub][i0 + 3]);
            pk.u.z = cvt_pk_bf16(s[sub][i0 + 4], s[sub][i0 + 5]); pk.u.w = cvt_pk_bf16(s[sub][i0 + 6], s[sub][i0 + 7]);
#pragma unroll
            for (int dsub = 0; dsub < 2; ++dsub) {
                union { u32x4 u; bf16x8 b; } vf;
                const LAS unsigned char* vrow2 = Vb + (dsub * 32 + ql) * 128 + hh * 8;
                const u32x2 lo = VPRE ? vlo[ks][dsub] : *(const LAS u32x2*)(vrow2 + (((ks * 2) << 4) ^ swz4)), hi = VPRE ? vhi[ks][dsub] : *(const LAS u32x2*)(vrow2 + (((ks * 2 + 1) << 4) ^ swz4));
                vf.u.x = lo.x; vf.u.y = lo.y; vf.u.z = hi.x; vf.u.w = hi.y;
                o[dsub] = __builtin_amdgcn_mfma_f32_32x32x16_bf16(vf.b, pk.b, o[dsub], 0, 0, 0);
            }
        }
    }
}

__device__ __forceinline__ void attn_phase(LAS unsigned char* lds, GAS const bf16_t* Z, GAS const bf16_t* vTs, GAS const bf16_t* vTw, GAS const bf16_t* kc, GAS const bf16_t* vcT, GAS bf16_t* O, int G, int bid) {
    LAS float* imp = (LAS float*)(lds + OFF_IMP);
    LAS float* score = (LAS float*)(lds + OFF_SCORE);
    LAS unsigned char* selb = lds + OFF_SEL;
    LAS unsigned* un = (LAS unsigned*)(lds + OFF_UN);
    LAS unsigned short* tlist = (LAS unsigned short*)(lds + OFF_LIST);
    int cnt = 0;
#define ATT_ISSUE(desc_, k_) do { const int kd_ = (desc_) >> 8, tl_ = (desc_) & 255; \
        GAS const bf16_t* kg_; GAS const bf16_t* vg_; \
        if (kd_ <= 1) { kg_ = kc + ((size_t)bg * 256 + tl_ * 64) * 64 + okc; vg_ = vcT + (size_t)bg * 64 * 256 + tl_ * 64 + ovc; } \
        else if (kd_ <= 3) { kg_ = Z + ((size_t)b * SEQ + tl_ * 64) * NZ + ZC_KSLC + g * 64 + okz; vg_ = vTs + (size_t)bg * 64 * SEQ + tl_ * 64 + ovt; } \
        else { kg_ = Z + ((size_t)b * SEQ + tl_ * 64) * NZ + ZC_KWIN + g * 64 + okz; vg_ = vTw + (size_t)bg * 64 * SEQ + tl_ * 64 + ovt; } \
        LAS unsigned char* sl_ = lds + ((k_) % 3) * SLOT_BYTES + wave * 1024; \
        __builtin_amdgcn_global_load_lds((GAS const unsigned*)kg_, (LAS unsigned*)sl_, 16, 0, 0); \
        __builtin_amdgcn_global_load_lds((GAS const unsigned*)vg_, (LAS unsigned*)(sl_ + 8192), 16, 0, 0); } while (0)
    for (int uidx = bid; uidx < 2048; uidx += G) {
        int tid = threadIdx.x; asm volatile("" : "+v"(tid));
        const int wave = __builtin_amdgcn_readfirstlane(tid >> 6), lane = tid & 63;
        const int hg = wave >> 1, qh = wave & 1, ql = lane & 31, hh = lane >> 5;
        const int qrow = qh * 32 + ql;
        const int kk = uidx >> 8, bb = uidx & 255, r = bb >> 5, bg = (bb & 31) ^ (((kk + 1) >> 1) & 1);
        const int qb = 63 - 8 * kk - ((kk & 1) ? (7 - r) : r);
        const int b = bg >> 1, g = bg & 1;
        const int head = g * 4 + hg;
        const float slope2 = exp2f(-(float)(head + 1)) * LOG2E;
        const int t = qb * 64 + qrow;
        const size_t token = (size_t)b * SEQ + t;
        const int lrow = wave * 8 + (lane >> 3), cfetch = (lane & 7) ^ ((lrow >> 1) & 7);
        const int okc = lrow * 64 + cfetch * 8, ovc = lrow * 256 + cfetch * 8, okz = lrow * NZ + cfetch * 8, ovt = lrow * SEQ + cfetch * 8;
        if (tid < 2) un[tid] = 0u;
        bf16x8 qf[4];
#pragma unroll
        for (int ds = 0; ds < 4; ++ds) qf[ds] = *(GAS const bf16x8*)(Z + token * NZ + ZC_Q + head * 64 + ds * 16 + hh * 8);
        f32x16 o[2];
        LAS float* outst = (LAS float*)(lds + OFF_IMP) + wave * 2048 + lane;
        float prim[8]; float carry = 0.f;
        GAS const bf16_t* gzp = Z + token * NZ + ZC_GNSA + head * 3;
        const float gate0 = __uint_as_float((unsigned)gzp[0] << 16), gate1 = __uint_as_float((unsigned)gzp[1] << 16), gate2 = __uint_as_float((unsigned)gzp[2] << 16);
        float m = NEGV, l = 0.f, inv_l = 0.f;
        const int ntc = (qb >> 4) + 1, nA = 2 * ntc;
#define DESC_A(i_) ((i_) < ntc ? (i_) : (0x100 | ((i_) - ntc)))
        ATT_ISSUE(DESC_A(0), cnt); ATT_ISSUE(DESC_A(1), cnt + 1);
        for (int i = 0; i < nA; ++i) {
            if (i + 1 < nA) asm volatile("s_waitcnt vmcnt(2)" ::: "memory"); else asm volatile("s_waitcnt vmcnt(0)" ::: "memory");
            __builtin_amdgcn_s_barrier(); asm volatile("" ::: "memory");
            if (i + 2 < nA) ATT_ISSUE(DESC_A(i + 2), cnt + 2);
            const LAS unsigned char* Kb = lds + (cnt % 3) * SLOT_BYTES; const LAS unsigned char* Vb = Kb + 8192;
            if (i < ntc) {
                if (1024 * i + 1039 <= 64 * qb) tile_compute<0, true>(Kb, Vb, qf, o, m, l, 0.f, i, t, slope2, true, qb, ql, hh, prim, carry);
                else tile_compute<0, false>(Kb, Vb, qf, o, m, l, 0.f, i, t, slope2, true, qb, ql, hh, prim, carry);
            } else {
                const int tc = i - ntc;
                if (tc == 0) {
                    inv_l = l > 0.f ? 1.0f / l : 0.f;
#pragma unroll
                    for (int e = 0; e < 16; ++e) { o[0][e] = 0.f; o[1][e] = 0.f; }
                }
                if (1024 * tc + 1039 <= 64 * qb) tile_compute<1, true>(Kb, Vb, qf, o, m, l, inv_l, tc, t, slope2, true, qb, ql, hh, prim, carry);
                else tile_compute<1, false>(Kb, Vb, qf, o, m, l, inv_l, tc, t, slope2, true, qb, ql, hh, prim, carry);
#pragma unroll
                for (int k = 0; k < 8; ++k) imp[(hg * 64 + qrow) * IMP_PITCH + tc * 16 + 2 * k + hh] = prim[k];
            }
            ++cnt;
        }
        __syncthreads();
        int tid2 = threadIdx.x; asm volatile("" : "+v"(tid2));
#pragma unroll
        for (int i = 0; i < 8; ++i) {
            const int idx = tid2 + 512 * i, q = idx >> 6, j = idx & 63;
            float sc;
            if (j > qb) sc = NEGV;
            else if (j == 0 || j == qb || j == qb - 1) sc = 1e9f;
            else sc = ((imp[(0 * 64 + q) * IMP_PITCH + j] + imp[(1 * 64 + q) * IMP_PITCH + j]) + imp[(2 * 64 + q) * IMP_PITCH + j]) + imp[(3 * 64 + q) * IMP_PITCH + j];
            score[q * IMP_PITCH + j] = sc;
        }
        __syncthreads();
        {
            const int q = tid2 >> 3, jb = tid2 & 7;
            unsigned long long ownk[8]; int rank[8];
#pragma unroll
            for (int e = 0; e < 8; ++e) { const float sv = score[q * IMP_PITCH + jb * 8 + e]; const unsigned u = sv > 0.f ? __float_as_uint(sv) : 0u; ownk[e] = ((unsigned long long)u << 6) | (unsigned)(63 - (jb * 8 + e)); rank[e] = 0; }
#pragma unroll 4
            for (int j2 = 0; j2 <= qb; ++j2) {
                const float v = score[q * IMP_PITCH + j2];
                const unsigned u = v > 0.f ? __float_as_uint(v) : 0u;
                const unsigned long long kj = ((unsigned long long)u << 6) | (unsigned)(63 - j2);
#pragma unroll
                for (int e = 0; e < 8; ++e) rank[e] += (kj > ownk[e]) ? 1 : 0;
            }
            unsigned byte = 0;
#pragma unroll
            for (int e = 0; e < 8; ++e) byte |= (rank[e] < 16 ? 1u : 0u) << e;
            selb[q * 8 + jb] = (unsigned char)byte;
            atomicOr((unsigned*)(un + (jb >> 2)), byte << (8 * (jb & 3)));
        }
        __syncthreads();
#pragma unroll
        for (int i = 0; i < 16; ++i) { outst[i * 64] = gate0 * o[0][i]; outst[(16 + i) * 64] = gate0 * o[1][i]; }
        const u32x2 selw = *(const LAS u32x2*)(selb + qrow * 8);
        const unsigned long long selmask = ((unsigned long long)selw.y << 32) | selw.x;
        unsigned long long unmask = ((unsigned long long)un[1] << 32) | un[0];
        unmask &= (qb >= 63) ? ~0ull : ((1ull << (qb + 1)) - 1ull);
        const int nslc = (int)__builtin_popcountll(unmask);
        const int j0 = qb >= 8 ? qb - 8 : 0;
        const int nB = nslc + (qb - j0 + 1);
        if (tid2 < 64) { if ((unmask >> tid2) & 1ull) { const int pos = (tid2 >= 63) ? 0 : (int)__builtin_popcountll(unmask >> (tid2 + 1)); tlist[pos] = (unsigned short)(((tid2 == qb) ? 0x300 : 0x200) | tid2); } }
        else if (tid2 < 73) { const int w = tid2 - 64, j = qb - w; if (j >= j0) tlist[nslc + w] = (unsigned short)(((j == qb || j == qb - 8) ? 0x500 : 0x400) | j); }
        __syncthreads();
#define DESC_B(i_) ((int)__builtin_amdgcn_readfirstlane((unsigned)tlist[(i_)]))
        m = NEGV; l = 0.f;
#pragma unroll
        for (int e = 0; e < 16; ++e) { o[0][e] = 0.f; o[1][e] = 0.f; }
        ATT_ISSUE(DESC_B(0), cnt); ATT_ISSUE(DESC_B(1), cnt + 1);
        for (int i = 0; i < nB; ++i) {
            if (i + 1 < nB) asm volatile("s_waitcnt vmcnt(2)" ::: "memory"); else asm volatile("s_waitcnt vmcnt(0)" ::: "memory");
            __builtin_amdgcn_s_barrier(); asm volatile("" ::: "memory");
            if (i + 2 < nB) { const int dn = DESC_B(i + 2); ATT_ISSUE(dn, cnt + 2); }
            const LAS unsigned char* Kb = lds + (cnt % 3) * SLOT_BYTES; const LAS unsigned char* Vb = Kb + 8192;
            const int dsc = DESC_B(i), kind = dsc >> 8, j = dsc & 255;
            if (i == nslc) {
                const float sc = l > 0.f ? gate1 / l : 0.f;
#pragma unroll
                for (int e = 0; e < 16; ++e) { outst[e * 64] += sc * o[0][e]; outst[(16 + e) * 64] += sc * o[1][e]; o[0][e] = 0.f; o[1][e] = 0.f; }
                m = NEGV; l = 0.f;
            }
            if (kind == 2) tile_compute<2, true>(Kb, Vb, qf, o, m, l, 0.f, j, t, slope2, ((selmask >> j) & 1ull) != 0ull, qb, ql, hh, prim, carry);
            else if (kind == 3) tile_compute<2, false>(Kb, Vb, qf, o, m, l, 0.f, j, t, slope2, ((selmask >> j) & 1ull) != 0ull, qb, ql, hh, prim, carry);
            else if (kind == 4) tile_compute<3, true>(Kb, Vb, qf, o, m, l, 0.f, j, t, slope2, true, qb, ql, hh, prim, carry);
            else tile_compute<3, false>(Kb, Vb, qf, o, m, l, 0.f, j, t, slope2, true, qb, ql, hh, prim, carry);
            ++cnt;
        }
        {
            const float sc = l > 0.f ? gate2 / l : 0.f;
#pragma unroll
            for (int e = 0; e < 16; ++e) { o[0][e] = outst[e * 64] + sc * o[0][e]; o[1][e] = outst[(16 + e) * 64] + sc * o[1][e]; }
        }
        GAS bf16_t* op = O + token * 512 + head * 64 + 4 * hh;
#pragma unroll
        for (int dsub = 0; dsub < 2; ++dsub)
#pragma unroll
            for (int i4 = 0; i4 < 4; ++i4) {
                u32x2 w; w.x = cvt_pk_bf16(o[dsub][4 * i4 + 0], o[dsub][4 * i4 + 1]); w.y = cvt_pk_bf16(o[dsub][4 * i4 + 2], o[dsub][4 * i4 + 3]);
                *(GAS u32x2*)(op + dsub * 32 + 8 * i4) = w;
            }
        __syncthreads();
    }
#undef ATT_ISSUE
#undef DESC_A
#undef DESC_B
}
}

#define XB_TMO      128
#define XB_XCNT(j)  (256  + 64 * (j))
#define XB_XSUB(j)  (1280 + 64 * (j))
#define XB_XGEN(j)  (2304 + 64 * (j))
#define XB_TOP      3328
#define XB_TOPGEN   3392
#define XCD_BAR_WORDS 3456
#define XB_SPIN_CAP (1u << 18)

__device__ __forceinline__ unsigned xb_ld(unsigned* p)              { return __hip_atomic_load(p, __ATOMIC_RELAXED, __HIP_MEMORY_SCOPE_AGENT); }
__device__ __forceinline__ unsigned xb_add(unsigned* p, unsigned v) { return __hip_atomic_fetch_add(p, v, __ATOMIC_RELAXED, __HIP_MEMORY_SCOPE_AGENT); }
__device__ __forceinline__ unsigned xb_xcc_id() { return (unsigned)__builtin_amdgcn_s_getreg((3 << 11) | 20) & 0xFu; }
#define XB_SPIN(cond, bar) do { unsigned _sp = 0; while (cond) { __builtin_amdgcn_s_sleep(1); \
    if ((++_sp & 255u) == 0u) { if (xb_ld(&(bar)[XB_TMO])) break; if (_sp > XB_SPIN_CAP) { atomicAdd(&(bar)[XB_TMO], 1u); break; } } } } while (0)

struct XcdBarrier {
    unsigned* bar; unsigned x;
    volatile LAS unsigned* st;
};

__device__ __forceinline__ XcdBarrier xcd_barrier_post(unsigned* bar, volatile LAS unsigned* st) {
    XcdBarrier b; b.bar = bar; b.x = xb_xcc_id(); b.st = st;
    if (threadIdx.x == 0) (void)xb_add(&bar[XB_XCNT(b.x)], 1u);
    return b;
}
__device__ __forceinline__ void xcd_barrier_complete(unsigned* bar, unsigned x, unsigned& nloc, unsigned& nx) {
    const unsigned G = gridDim.x * gridDim.y * gridDim.z;
    unsigned sum, cnt, mine, sp = 0u;
    for (;;) {
        sum = 0u; cnt = 0u; mine = 0u;
#pragma unroll
        for (unsigned j = 0; j < 16; ++j) { const unsigned c = xb_ld(&bar[XB_XCNT(j)]); sum += c; cnt += (c > 0u) ? 1u : 0u; mine = (j == x) ? c : mine; }
        if (sum == G) break;
        __builtin_amdgcn_s_sleep(1);
        if ((++sp & 255u) == 0u) { if (xb_ld(&bar[XB_TMO])) break; if (sp > XB_SPIN_CAP) { atomicAdd(&bar[XB_TMO], 1u); break; } }
    }
    nloc = mine > 0u ? mine : 1u; nx = cnt > 0u ? cnt : 1u;
}

__device__ __forceinline__ void xcd_barrier(const XcdBarrier& b) {
    asm volatile("s_waitcnt vmcnt(0)" ::: "memory");
    __syncthreads();
    if (threadIdx.x == 0) {
        unsigned* bar = b.bar;
        __builtin_amdgcn_s_waitcnt(0);
        unsigned nloc = b.st[0], nx = b.st[1];
        if (nloc == 0u) { xcd_barrier_complete(bar, b.x, nloc, nx); b.st[0] = nloc; b.st[1] = nx; }
        const unsigned old = xb_add(&bar[XB_XSUB(b.x)], 1u);
        const unsigned gen = old / nloc;
        if (old + 1u == (gen + 1u) * nloc) {
            __builtin_amdgcn_fence(__ATOMIC_RELEASE, "agent");
            asm volatile("s_waitcnt vmcnt(0)" ::: "memory");
            const unsigned og = xb_add(&bar[XB_TOP], 1u);
            const unsigned tg = og / nx;
            if (og + 1u == (tg + 1u) * nx) xb_add(&bar[XB_TOPGEN], 1u);
            else XB_SPIN(xb_ld(&bar[XB_TOPGEN]) == tg, bar);
            __builtin_amdgcn_fence(__ATOMIC_ACQUIRE, "agent");
            xb_add(&bar[XB_XGEN(b.x)], 1u);
            asm volatile("s_waitcnt vmcnt(0)" ::: "memory");
        } else {
            XB_SPIN(xb_ld(&bar[XB_XGEN(b.x)]) == gen, bar);
            __builtin_amdgcn_fence(__ATOMIC_ACQUIRE, "agent");
            asm volatile("s_waitcnt vmcnt(0)" ::: "memory");
        }
    }
    __syncthreads();
}

struct Args { const float* in[28]; float* out; unsigned char* ws; };

constexpr int PTAB_OFF = 143360;
__device__ __forceinline__ GAS const float* karg(const LAS unsigned char* lds, int slot) {
    const LAS unsigned* pt = (const LAS unsigned*)(lds + PTAB_OFF) + 2 * slot;
    const unsigned lo = __builtin_amdgcn_readfirstlane(pt[0]), hi = __builtin_amdgcn_readfirstlane(pt[1]);
    return (GAS const float*)(((unsigned long long)hi << 32) | lo);
}
#define INP(i) karg(lds, i)
#define WSB(off) ((GAS bf16_t*)((GAS unsigned char*)karg(lds, 29) + (off)))
#define WSF(off) ((GAS float*)((GAS unsigned char*)karg(lds, 29) + (off)))
#define XOUT ((GAS float*)karg(lds, 28))
constexpr int XBST_OFF = PTAB_OFF + 512;
#define GRID_BAR() do { XcdBarrier b_; b_.bar = (unsigned*)(GAS unsigned*)karg(lds, 29); b_.x = xb_xcc_id(); b_.st = (volatile LAS unsigned*)(lds + XBST_OFF); xcd_barrier(b_); } while (0)

__global__ void __launch_bounds__(512, 2) mega_fwd(Args a) {
    extern __shared__ __attribute__((aligned(16))) unsigned char lds_raw[];
    LAS unsigned char* lds = (LAS unsigned char*)lds_raw;
    cg::grid_group grid = cg::this_grid();
    const int tid = threadIdx.x, lane = tid & 63, wave = __builtin_amdgcn_readfirstlane(tid >> 6);
    const int G = gridDim.x, bid = blockIdx.x;
    const int gw = bid * 8 + wave, NGW = G * 8;
    if (tid == 0) {
        LAS unsigned long long* pt = (LAS unsigned long long*)(lds + PTAB_OFF);
#pragma unroll
        for (int i = 0; i < 28; ++i) pt[i] = (unsigned long long)a.in[i];
        pt[28] = (unsigned long long)a.out; pt[29] = (unsigned long long)a.ws;
        volatile LAS unsigned* st = (volatile LAS unsigned*)(lds + XBST_OFF); st[0] = 0u; st[1] = 0u;
    }
    __syncthreads();
    (void)xcd_barrier_post((unsigned*)a.ws, (volatile LAS unsigned*)(lds + XBST_OFF));

    {
        LAS float* cact = (LAS float*)lds;
        GAS const float* c = INP(1);
        for (int i = tid; i < NBATCH * D; i += 512) { const int bb = i >> 10, k = i & 1023; cact[k * 16 + bb] = siluf_(c[i]); }
        __syncthreads();
        for (int item = bid; item < NADA / 64; item += G) {
            const int j = item * 64 + lane; GAS const float* w = INP(4) + j + (size_t)(wave * 128) * NADA;
            float acc[16];
#pragma unroll
            for (int bb = 0; bb < 16; ++bb) acc[bb] = 0.f;
#pragma unroll 16
            for (int k = 0; k < 128; ++k) {
                const float wv = w[(size_t)k * NADA];
                const LAS f32x4* cp = (const LAS f32x4*)(cact + (wave * 128 + k) * 16);
                const f32x4 c0 = cp[0], c1 = cp[1], c2 = cp[2], c3 = cp[3];
                acc[0] += c0.x * wv; acc[1] += c0.y * wv; acc[2] += c0.z * wv; acc[3] += c0.w * wv;
                acc[4] += c1.x * wv; acc[5] += c1.y * wv; acc[6] += c1.z * wv; acc[7] += c1.w * wv;
                acc[8] += c2.x * wv; acc[9] += c2.y * wv; acc[10] += c2.z * wv; acc[11] += c2.w * wv;
                acc[12] += c3.x * wv; acc[13] += c3.y * wv; acc[14] += c3.z * wv; acc[15] += c3.w * wv;
            }
            LAS float* part = (LAS float*)(lds + 65536);
#pragma unroll
            for (int bb = 0; bb < 16; ++bb) part[wave * 1024 + bb * 64 + lane] = acc[bb];
            __syncthreads();
#pragma unroll
            for (int h = 0; h < 2; ++h) {
                const int bsel = (tid >> 6) + 8 * h, col = tid & 63;
                float sum = 0.f;
#pragma unroll
                for (int w8 = 0; w8 < 8; ++w8) sum += part[w8 * 1024 + bsel * 64 + col];
                WSF(WS_ADA)[(size_t)bsel * NADA + item * 64 + col] = sum + INP(5)[item * 64 + col];
            }
            __syncthreads();
        }
        LAS float* scr = (LAS float*)(lds + 65536 + wave * 8448);
        constexpr int I_WA = 1024;
        constexpr int I_IN = 16 * (2 * DFF / 32), I_OUT = (DFF / 64) * 32, I_MIX = 16 * (NZ / 32), I_WB = 8 * 32, I_MO = 16 * 32, I_C1 = 32 * 8, I_C2 = 4 * 8;
        constexpr int NITEMS = I_WA + 2 * I_IN + 2 * I_OUT + I_MIX + I_WB + I_MO + 2 * I_C1 + 2 * I_C2;
        for (int it = gw; it < NITEMS; it += NGW) {
            int r = it;
            if (r < I_WA) {
                const int gq = r >> 8, rem = r & 255, c0 = (rem >> 4) * 8, n0 = (rem & 15) * 64;
                GAS const float* pw = INP(11) + ((size_t)gq * 128 + c0) * 128; GAS const float* psc = INP(12) + gq * 128; GAS const float* wba = INP(19) + (size_t)gq * 128 * D + n0 + lane;
                float acc[8];
#pragma unroll
                for (int ci = 0; ci < 8; ++ci) acc[ci] = 0.f;
#pragma unroll 16
                for (int d = 0; d < 128; ++d) {
                    const float wv = wba[(size_t)d * D] * psc[d];
#pragma unroll
                    for (int ci = 0; ci < 8; ++ci) acc[ci] += pw[ci * 128 + d] * wv;
                }
                u32x4 o; o.x = cvt_pk_bf16(acc[0], acc[1]); o.y = cvt_pk_bf16(acc[2], acc[3]); o.z = cvt_pk_bf16(acc[4], acc[5]); o.w = cvt_pk_bf16(acc[6], acc[7]);
                *(GAS u32x4*)(WSB(WS_WA) + (size_t)(n0 + lane) * 512 + gq * 128 + c0) = o;
                continue;
            }
            r -= I_WA;
            if (r < I_IN) { tr_item(INP(6), 2 * DFF, WSB(WS_W1IN), D, 1, scr, r, 2 * DFF / 32, lane); continue; } r -= I_IN;
            if (r < I_IN) { tr_item(INP(24), 2 * DFF, WSB(WS_W2IN), D, 1, scr, r, 2 * DFF / 32, lane); continue; } r -= I_IN;
            if (r < I_OUT) { tr_item(INP(7), D, WSB(WS_W1OUT), DFF, 0, scr, r, 32, lane); continue; } r -= I_OUT;
            if (r < I_OUT) { tr_item(INP(25), D, WSB(WS_W2OUT), DFF, 0, scr, r, 32, lane); continue; } r -= I_OUT;
            if (r < I_MIX) { tr_item(INP(10), 3864, WSB(WS_WMIX), D, 2, scr, r, NZ / 32, lane); continue; } r -= I_MIX;
            if (r < I_WB) { tr_item(INP(20), D, WSB(WS_WB), 512, 0, scr, r, 32, lane); continue; } r -= I_WB;
            if (r < I_MO) { tr_item(INP(21), D, WSB(WS_WMO), D, 0, scr, r, 32, lane); continue; } r -= I_MO;
            if (r < I_C1) { tr_item(INP(14), 256, WSB(WS_CKW1), 2048, 0, scr, r, 8, lane); continue; } r -= I_C1;
            if (r < I_C1) { tr_item(INP(17), 256, WSB(WS_CVW1), 2048, 0, scr, r, 8, lane); continue; } r -= I_C1;
            if (r < I_C2) { tr_item(INP(15), 64, WSB(WS_CKW2), 256, 3, scr, r, 8, lane); continue; } r -= I_C2;
            tr_item(INP(18), 64, WSB(WS_CVW2), 256, 3, scr, r, 8, lane);
        }
    }
    grid.sync();
    ln_rows<false, true, false, false, false, false>(INP(0), WSB(WS_H), XOUT, WSB(WS_H), INP(2), INP(3), WSF(WS_ADA), 0, INP(2), INP(3), gw, NGW, lane);
    GRID_BAR();
    pg8::StaticOrder S;
#ifndef REP_G1
#define REP_G1 1
#endif
#pragma unroll 1
    for (int rep = 0; rep < REP_G1; ++rep)
    { pg8::Gemm g{WSB(WS_H), WSB(WS_W1IN), M, 2 * DFF, D, D, D}; S.init(M, 2 * DFF, G, bid); pg8::EpiSwiglu E{WSB(WS_ACT)}; pg8::gemm_phase(lds, g, S, E); }
    GRID_BAR();
    { pg8::Gemm g{WSB(WS_ACT), WSB(WS_W1OUT), M, D, DFF, DFF, DFF}; S.init(M, D, G, bid); pg8::EpiY E{WSB(WS_H), WSF(WS_ADA) + 2 * D, 0.5f}; pg8::gemm_phase(lds, g, S, E); }
    GRID_BAR();
    ln_rows<true, true, true, true, false, true>(INP(0), WSB(WS_H), XOUT, WSB(WS_H), INP(8), INP(9), WSF(WS_ADA), 1, INP(2), INP(3), gw, NGW, lane);
    GRID_BAR();
#if MIXER_MODE >= 1
    { pg8::Gemm g{WSB(WS_H), WSB(WS_WMIX), M, NZ, D, D, D}; S.init(M, NZ, G, bid); pg8::EpiZ E{WSB(WS_ACT)}; pg8::gemm_phase(lds, g, S, E); }
    GRID_BAR();
    {
        constexpr int I_DELTA = M / 32, I_VT = 2 * 32 * 64, I_BLK = 2 * 8192 / 4;
        LAS unsigned char* tsc = lds + wave * 9216;
        GAS const bf16_t* Zp = WSB(WS_ACT);
#define UNPK8(v_, f_) do { f_[0] = bf_lo(v_.x); f_[1] = bf_hi(v_.x); f_[2] = bf_lo(v_.y); f_[3] = bf_hi(v_.y); f_[4] = bf_lo(v_.z); f_[5] = bf_hi(v_.z); f_[6] = bf_lo(v_.w); f_[7] = bf_hi(v_.w); } while (0)
        for (int it = gw; it < I_DELTA + I_VT + I_BLK; it += NGW) {
            int r = it;
            if (r < I_DELTA) {
                const int tok0 = r * 32, tpos0 = tok0 & (SEQ - 1), w = 2 << (lane >> 4);
                GAS const bf16_t* zp = Zp + (size_t)tok0 * NZ + lane * 8;
                GAS bf16_t* dp = WSB(WS_DELTA) + (size_t)tok0 * 512 + lane * 8;
                float sum[8];
#pragma unroll
                for (int e = 0; e < 8; ++e) sum[e] = 0.f;
#pragma unroll
                for (int i = 1; i < 16; ++i) {
                    if (i < w && tpos0 - i >= 0) {
                        const u32x4 v = *(GAS const u32x4*)(zp - (long)i * NZ); float f[8]; UNPK8(v, f);
#pragma unroll
                        for (int e = 0; e < 8; ++e) sum[e] += f[e];
                    }
                }
#pragma unroll 1
                for (int s4 = 0; s4 < 32; s4 += 4) {
                    u32x4 cur[4], old[4];
#pragma unroll
                    for (int q = 0; q < 4; ++q) {
                        cur[q] = *(GAS const u32x4*)(zp + (long)(s4 + q) * NZ);
                        const int back = s4 + q - w + 1;
                        old[q] = (tpos0 + back >= 0) ? *(GAS const u32x4*)(zp + (long)back * NZ) : (u32x4){0u, 0u, 0u, 0u};
                    }
#pragma unroll
                    for (int q = 0; q < 4; ++q) {
                        float f[8], fo[8]; UNPK8(cur[q], f); UNPK8(old[q], fo);
                        const int tpos = tpos0 + s4 + q; const int cnt = (tpos + 1) < w ? (tpos + 1) : w;
                        const float ic = 1.0f / (float)cnt;
#pragma unroll
                        for (int e = 0; e < 8; ++e) sum[e] += f[e];
                        u32x4 o; o.x = cvt_pk_bf16(sum[0] * ic - f[0], sum[1] * ic - f[1]); o.y = cvt_pk_bf16(sum[2] * ic - f[2], sum[3] * ic - f[3]);
                        o.z = cvt_pk_bf16(sum[4] * ic - f[4], sum[5] * ic - f[5]); o.w = cvt_pk_bf16(sum[6] * ic - f[6], sum[7] * ic - f[7]);
                        *(GAS u32x4*)(dp + (size_t)(s4 + q) * 512) = o;
#pragma unroll
                        for (int e = 0; e < 8; ++e) sum[e] -= fo[e];
                    }
                }
                continue;
            }
            r -= I_DELTA;
            if (r < I_VT) {
                const int which = r >> 11, rem = r & 2047, bg = rem >> 6, tile = rem & 63, b = bg >> 1, g = bg & 1;
                GAS const bf16_t* src = Zp + ((size_t)b * SEQ + tile * 64) * NZ + (which ? ZC_VWIN : ZC_VSLC) + g * 64;
                GAS bf16_t* dst = (which ? WSB(WS_VTW) : WSB(WS_VTS)) + (size_t)bg * 64 * SEQ + tile * 64;
                u32x4 vv[8];
#pragma unroll
                for (int i = 0; i < 8; ++i) vv[i] = *(GAS const u32x4*)(src + (size_t)(i * 8 + (lane >> 3)) * NZ + (lane & 7) * 8);
#pragma unroll
                for (int i = 0; i < 8; ++i) {
                    const int row = i * 8 + (lane >> 3), ch = lane & 7; const u32x4 v = vv[i];
                    LAS bf16_t* tp = (LAS bf16_t*)tsc + (ch * 8) * 72 + row;
                    tp[0 * 72] = (bf16_t)(v.x & 0xffffu); tp[1 * 72] = (bf16_t)(v.x >> 16); tp[2 * 72] = (bf16_t)(v.y & 0xffffu); tp[3 * 72] = (bf16_t)(v.y >> 16);
                    tp[4 * 72] = (bf16_t)(v.z & 0xffffu); tp[5 * 72] = (bf16_t)(v.z >> 16); tp[6 * 72] = (bf16_t)(v.w & 0xffffu); tp[7 * 72] = (bf16_t)(v.w >> 16);
                }
                LDS_WAIT(); asm volatile("" ::: "memory");
#pragma unroll
                for (int i = 0; i < 8; ++i) {
                    const int d = i * 8 + (lane >> 3), ch = lane & 7;
                    const u32x4 v = *(const LAS u32x4*)(tsc + d * 144 + ch * 16);
                    *(GAS u32x4*)(dst + (size_t)d * SEQ + ch * 8) = v;
                }
                LDS_WAIT(); asm volatile("" ::: "memory");
                continue;
            }
            r -= I_VT;
            {
                const int which = r >> 11, rowbase = (r & 2047) * 4, bg = rowbase >> 8, b = bg >> 1, g = bg & 1;
                GAS const float* pos = which ? INP(16) : INP(13);
                GAS bf16_t* dst = (which ? WSB(WS_VBLK) : WSB(WS_KBLK)) + (size_t)rowbase * 2048;
                GAS const bf16_t* src = Zp + (size_t)b * SEQ * NZ + (which ? ZC_VCMP : ZC_KCMP) + g * 64;
                u32x4 vv[4][4];
#pragma unroll
                for (int rr = 0; rr < 4; ++rr) {
                    const int n = (rowbase + rr) & 255;
#pragma unroll
                    for (int i = 0; i < 4; ++i) {
                        const int ch = lane + 64 * i, pp = ch >> 3, dc = ch & 7;
                        vv[rr][i] = (n < 255) ? *(GAS const u32x4*)(src + (size_t)(16 * n + pp) * NZ + dc * 8) : (u32x4){0u, 0u, 0u, 0u};
                    }
                }
#pragma unroll
                for (int i = 0; i < 4; ++i) {
                    const int ch = lane + 64 * i, pp = ch >> 3, dc = ch & 7;
                    const f32x4 p0 = *(GAS const f32x4*)(pos + pp * 64 + dc * 8), p1 = *(GAS const f32x4*)(pos + pp * 64 + dc * 8 + 4);
#pragma unroll
                    for (int rr = 0; rr < 4; ++rr) {
                        const int n = (rowbase + rr) & 255; const u32x4 v = vv[rr][i];
                        u32x4 o = (u32x4){0u, 0u, 0u, 0u};
                        if (n < 255) {
                            o.x = cvt_pk_bf16(bf_lo(v.x) + p0.x, bf_hi(v.x) + p0.y); o.y = cvt_pk_bf16(bf_lo(v.y) + p0.z, bf_hi(v.y) + p0.w);
                            o.z = cvt_pk_bf16(bf_lo(v.z) + p1.x, bf_hi(v.z) + p1.y); o.w = cvt_pk_bf16(bf_lo(v.w) + p1.z, bf_hi(v.w) + p1.w);
                        }
                        *(GAS u32x4*)(dst + (size_t)rr * 2048 + ch * 8) = o;
                    }
                }
            }
        }
#undef UNPK8
    }
    GRID_BAR();
#if MIXER_MODE >= 2
#pragma unroll 1
    for (int s = 0; s < 2; ++s) {
        pg8::Gemm g{s ? WSB(WS_VBLK) : WSB(WS_KBLK), s ? WSB(WS_CVW1) : WSB(WS_CKW1), 8192, 256, 2048, 2048, 2048}; S.init(8192, 256, G, s ? (bid + G - 32) % G : bid);
        pg8::EpiCmp1 E{s ? WSB(WS_HIDV) : WSB(WS_HIDK)}; pg8::gemm_phase(lds, g, S, E);
    }
    __syncthreads();
#pragma unroll 1
    for (int s = 0; s < 2; ++s) {
        pg8::Gemm g{s ? WSB(WS_HIDV) : WSB(WS_HIDK), s ? WSB(WS_CVW2) : WSB(WS_CKW2), 8192, 256, 256, 256, 256}; S.init(8192, 256, G, s ? (bid + G - 32) % G : bid);
        pg8::EpiCmp2 E{s ? WSB(WS_VCT) : WSB(WS_KC), s}; pg8::gemm_phase(lds, g, S, E);
    }
    GRID_BAR();
#ifndef REP_ATT
#define REP_ATT 1
#endif
#pragma unroll 1
    for (int rep = 0; rep < REP_ATT; ++rep)
        att::attn_phase(lds, WSB(WS_ACT), WSB(WS_VTS), WSB(WS_VTW), WSB(WS_KC), WSB(WS_VCT), WSB(WS_O), G, bid);
    GRID_BAR();
#endif
    { pg8::Gemm g{WSB(WS_DELTA), WSB(WS_WA), M, D, 512, 512, 512}; S.init(M, D, G, bid); pg8::EpiGate E{WSB(WS_ACT), WSB(WS_H), ZC_GA, 0}; pg8::gemm_phase(lds, g, S, E); }
#if MIXER_MODE >= 2
    { pg8::Gemm g{WSB(WS_O), WSB(WS_WB), M, D, 512, 512, 512}; S.init(M, D, G, bid); pg8::EpiGate E{WSB(WS_ACT), WSB(WS_H), ZC_GB, 1}; pg8::gemm_phase(lds, g, S, E); }
#endif
    GRID_BAR();
    { pg8::Gemm g{WSB(WS_H), WSB(WS_WMO), M, D, D, D, D}; S.init(M, D, G, bid); pg8::EpiY E{WSB(WS_DELTA), WSF(WS_ADA) + 5 * D, 1.0f}; pg8::gemm_phase(lds, g, S, E); }
    GRID_BAR();
#else
    for (size_t i = (size_t)bid * 512 + tid; i < (size_t)M * D / 4; i += (size_t)G * 512) { f32x4 v = ((GAS f32x4*)XOUT)[i]; ((GAS f32x4*)XOUT)[i] = v * ALPHA; }
    GRID_BAR();
#endif
    ln_rows<true, true, true, false, true, true>(XOUT, WSB(WS_DELTA), WSB(WS_DELTA), WSB(WS_H), INP(22), INP(23), WSF(WS_ADA), 2, INP(2), INP(3), gw, NGW, lane);
    GRID_BAR();
    { pg8::Gemm g{WSB(WS_H), WSB(WS_W2IN), M, 2 * DFF, D, D, D}; S.init(M, 2 * DFF, G, bid); pg8::EpiSwiglu E{WSB(WS_ACT)}; pg8::gemm_phase(lds, g, S, E); }
    GRID_BAR();
    { pg8::Gemm g{WSB(WS_ACT), WSB(WS_W2OUT), M, D, DFF, DFF, DFF}; S.init(M, D, G, bid); pg8::EpiY E{WSB(WS_H), WSF(WS_ADA) + 8 * D, 0.5f}; pg8::gemm_phase(lds, g, S, E); }
    GRID_BAR();
    ln_rows<true, false, true, false, true, false>(WSB(WS_DELTA), WSB(WS_H), XOUT, WSB(WS_H), INP(26), INP(27), WSF(WS_ADA), 0, INP(2), INP(3), gw, NGW, lane);
}

extern "C" void kernel_launch(void* const* d_in, const int* in_sizes, int n_in, void* d_out, int out_size, void* d_ws, size_t ws_size, hipStream_t stream) {
    static int grid = 0;
    if (grid == 0) {
        if (n_in != 28 || out_size != M * D || ws_size < WS_END) { fprintf(stderr, "kernel_launch: unexpected shapes (n_in %d out %d ws %zu)\n", n_in, out_size, ws_size); grid = -1; return; }
        int dev = 0, cus = 0, per_cu = 0;
        hipGetDevice(&dev);
        hipDeviceGetAttribute(&cus, hipDeviceAttributeMultiprocessorCount, dev);
        if (hipFuncSetAttribute((const void*)mega_fwd, hipFuncAttributeMaxDynamicSharedMemorySize, LDS_BYTES) != hipSuccess) { fprintf(stderr, "kernel_launch: hipFuncSetAttribute failed\n"); grid = -1; return; }
        if (hipOccupancyMaxActiveBlocksPerMultiprocessor(&per_cu, (const void*)mega_fwd, 512, LDS_BYTES) != hipSuccess || per_cu < 1) { fprintf(stderr, "kernel_launch: occupancy query says %d\n", per_cu); per_cu = 1; }
        (void)hipGetLastError();
        grid = cus * per_cu;
    }
    if (grid < 0) return;
    if (hipMemsetAsync(d_ws, 0, 16384, stream) != hipSuccess) { fprintf(stderr, "kernel_launch: hipMemsetAsync of the barrier words failed\n"); return; }
    Args a{};
    for (int i = 0; i < 28; ++i) a.in[i] = (const float*)d_in[i];
    a.out = (float*)d_out; a.ws = (unsigned char*)d_ws;
    void* args[] = {&a};
    hipError_t e = hipLaunchCooperativeKernel((const void*)mega_fwd, dim3(grid), dim3(512), args, LDS_BYTES, stream);
    if (e != hipSuccess) fprintf(stderr, "cooperative launch failed: %s (grid %d)\n", hipGetErrorString(e), grid);
}
```

```cpp
#include <hip/hip_runtime.h>
#include <hip/hip_cooperative_groups.h>
#include <cstdio>
#include <cstdint>
namespace cg = cooperative_groups;

#define LAS __attribute__((address_space(3)))
#define GAS __attribute__((address_space(1)))
typedef unsigned short bf16_t;
typedef short bf16x8 __attribute__((ext_vector_type(8)));
typedef float f32x4 __attribute__((ext_vector_type(4)));
typedef float f32x16 __attribute__((ext_vector_type(16)));
typedef unsigned u32x4 __attribute__((ext_vector_type(4)));
typedef unsigned u32x2 __attribute__((ext_vector_type(2)));

#ifndef MIXER_MODE
#define MIXER_MODE 2
#endif

constexpr int D = 1024, NBATCH = 16, SEQ = 4096, M = NBATCH * SEQ, DFF = 2816, NZ = 4096, NADA = 9 * D;
constexpr float ALPHA = 1.189207115002721f;
constexpr float LN_EPS = 1e-5f;
constexpr float LOG2E = 1.4426950408889634f;
constexpr int ZC_Q = 512, ZC_KCMP = 1024, ZC_VCMP = 1152, ZC_KSLC = 1280, ZC_VSLC = 1408, ZC_KWIN = 1536, ZC_VWIN = 1664, ZC_GNSA = 1792, ZC_GA = 2048, ZC_GB = 3072;

constexpr size_t MiB = 1u << 20;
constexpr size_t WS_ADA = 1 * MiB;
constexpr size_t WS_W1IN = 2 * MiB;
constexpr size_t WS_W1OUT = 13 * MiB;
constexpr size_t WS_W2IN = 19 * MiB;
constexpr size_t WS_W2OUT = 30 * MiB;
constexpr size_t WS_WMIX = 36 * MiB;
constexpr size_t WS_WA = 44 * MiB;
constexpr size_t WS_WB = 45 * MiB;
constexpr size_t WS_WMO = 46 * MiB;
constexpr size_t WS_CKW1 = 48 * MiB;
constexpr size_t WS_CVW1 = 49 * MiB;
constexpr size_t WS_CKW2 = 50 * MiB;
constexpr size_t WS_CVW2 = 50 * MiB + 512 * 1024;
constexpr size_t WS_KC = 51 * MiB;
constexpr size_t WS_VCT = 52 * MiB;
constexpr size_t WS_HIDK = 53 * MiB;
constexpr size_t WS_HIDV = 57 * MiB;
constexpr size_t WS_VTS = 64 * MiB;
constexpr size_t WS_VTW = 80 * MiB;
constexpr size_t WS_H = 96 * MiB;
constexpr size_t WS_DELTA = 224 * MiB;
constexpr size_t WS_O = 288 * MiB;
constexpr size_t WS_ACT = 352 * MiB;
constexpr size_t WS_KBLK = 864 * MiB;
constexpr size_t WS_VBLK = 896 * MiB;
constexpr size_t WS_END = 928 * MiB;

constexpr int LDS_BYTES = 147456;

__device__ __forceinline__ unsigned cvt_pk_bf16(float lo, float hi) { unsigned r; asm("v_cvt_pk_bf16_f32 %0, %1, %2" : "=v"(r) : "v"(lo), "v"(hi)); return r; }
__device__ __forceinline__ float bf_lo(unsigned u) { return __uint_as_float(u << 16); }
__device__ __forceinline__ float bf_hi(unsigned u) { return __uint_as_float(u & 0xffff0000u); }
__device__ __forceinline__ float fast_rcp(float x) { return __builtin_amdgcn_rcpf(x); }
__device__ __forceinline__ float fast_exp2(float x) { return __builtin_amdgcn_exp2f(x); }
__device__ __forceinline__ float sigmoidf_(float x) { return fast_rcp(1.0f + fast_exp2(-x * LOG2E)); }
__device__ __forceinline__ float siluf_(float x) { return x * sigmoidf_(x); }
__device__ __forceinline__ float gelu_tanh(float x) { const float u = 0.7978845608028654f * (x + 0.044715f * x * x * x); const float e = fast_exp2(2.0f * LOG2E * u); const float th = 1.0f - 2.0f * fast_rcp(e + 1.0f); return 0.5f * x * (1.0f + th); }
#define LDS_WAIT() asm volatile("s_waitcnt lgkmcnt(0)" ::: "memory")

namespace pg8 {
constexpr int BM = 256, BK = 64, HALF = 128, HTB = HALF * BK * 2, STAGE_BYTES = 8 * HTB, NXCD = 8, WGM = 8;
__host__ __device__ __forceinline__ int lds_byte(int r, int c) { const int st = (r >> 4) * 2 + (c >> 5), rr = r & 15, cc = c & 31, ob = rr * 64 + cc * 2; return st * 1024 + (ob ^ (((ob >> 9) & 1) << 5)); }
__host__ __device__ __forceinline__ void stage_rc(int b, int& R, int& C) { const int st = b / 1024, sb = b % 1024, swz = sb ^ (((sb >> 9) & 1) << 5); R = (st >> 1) * 16 + swz / 64; C = (st & 1) * 32 + (swz % 64) / 2; }
__host__ __device__ __forceinline__ int perm32(int rho) { const int n = rho >> 4, i = rho & 15; return 8 * (i >> 2) + 4 * n + (i & 3); }

struct Unit { int pm, pn; };
struct Gemm { GAS const bf16_t* A; GAS const bf16_t* Bt; int M, N, K, lda, ldb; };

struct StaticOrder {
    int nM, nN, nwg, G, c;
    __device__ void init(int M_, int N_, int G_, int c_) { nM = M_ / BM; nN = N_ / BM; nwg = nM * nN; G = G_; c = c_; }
    __device__ bool next(int i, Unit& u) const {
        const long L = (long)i * G + c; if (L >= nwg) return false;
        int wgid = (int)L; { const int q = nwg / NXCD, r = nwg % NXCD, xcd = wgid % NXCD, off = wgid / NXCD; wgid = (xcd < r ? xcd * (q + 1) : r * (q + 1) + (xcd - r) * q) + off; }
        const int nig = WGM * nN, gid = wgid / nig, fm = gid * WGM, gsz = (nM - fm) < WGM ? (nM - fm) : WGM;
        u.pm = fm + ((wgid % nig) % gsz); u.pn = (wgid % nig) / gsz; return true;
    }
};

template <class Epi>
__device__ __forceinline__ void gemm_phase(LAS unsigned char* lds, const Gemm g, const StaticOrder& S, const Epi& E) {
    int tid_ = threadIdx.x; asm volatile("" : "+v"(tid_));
    const int tid = tid_, wid = __builtin_amdgcn_readfirstlane(tid >> 6), lane = tid & 63, wr = wid >> 2, wc = wid & 3, fr = lane & 15, fq = lane >> 4;
    const int K = g.K, nt = K / BK;
    unsigned voffA[2], voffB[2];
#pragma unroll
    for (int i = 0; i < 2; ++i) { int R, C; stage_rc(tid * 16 + i * 8192, R, C); const int Rb = Epi::PERM ? ((R & ~31) + perm32(R & 31)) : R;
        voffA[i] = (unsigned)(R * g.lda + C) * 2u; voffB[i] = (unsigned)(Rb * g.ldb + C) * 2u; }
    const size_t kstep = (size_t)(BK * 2);
    const size_t hstepA = (size_t)HALF * g.lda * 2, hstepB = (size_t)HALF * g.ldb * 2;
    const size_t tstepA = 2 * hstepA, tstepB = 2 * hstepB;
    const unsigned ldsw = (unsigned)wid * 1024u;
    const int aoff = lds_byte(wr * 64 + fr, fq * 8), boff = lds_byte(wc * 32 + fr, fq * 8);
#define PG8_SA(b, h) (((b) * 2 + (h)) * HTB)
#define PG8_SB(b, h) ((4 + (b) * 2 + (h)) * HTB)
#define PG8_STAGE(bufoff, gbase, voff) do { _Pragma("unroll") for (int _i = 0; _i < 2; ++_i) \
        __builtin_amdgcn_global_load_lds((GAS const unsigned*)((gbase) + (voff)[_i]), (LAS unsigned*)(lds + (bufoff) + ldsw + _i * 8192), 16, 0, 0); } while (0)
#define PG8_LDA(dst, b, h) do { _Pragma("unroll") for (int m = 0; m < 4; ++m) _Pragma("unroll") for (int k = 0; k < 2; ++k) dst[m][k] = *(const LAS bf16x8*)(lds + PG8_SA(b, h) + aoff + m * 2048 + k * 1024); } while (0)
#define PG8_LDB(dst, b, h) do { _Pragma("unroll") for (int n = 0; n < 2; ++n) _Pragma("unroll") for (int k = 0; k < 2; ++k) dst[n][k] = *(const LAS bf16x8*)(lds + PG8_SB(b, h) + boff + n * 2048 + k * 1024); } while (0)
#define PG8_MMA(ai, bj, At, Bt) do { __builtin_amdgcn_s_setprio(1); _Pragma("unroll") for (int m = 0; m < 4; ++m) _Pragma("unroll") for (int n = 0; n < 2; ++n) _Pragma("unroll") for (int k = 0; k < 2; ++k) \
        acc[ai][bj][m][n] = __builtin_amdgcn_mfma_f32_16x16x32_bf16(Bt[n][k], At[m][k], acc[ai][bj][m][n], 0, 0, 0); __builtin_amdgcn_s_setprio(0); } while (0)
#define PG8_WAIT_V(n) asm volatile("s_waitcnt vmcnt(" #n ")" ::: "memory")
#define PG8_WAIT_L(n) asm volatile("s_waitcnt lgkmcnt(" #n ")" ::: "memory")
#define PG8_BAR __builtin_amdgcn_s_barrier()
#define PG8_SCHED __builtin_amdgcn_sched_barrier(0)
    Unit cur, nxt; int ui = 0;
    if (!S.next(0, cur)) return;
    f32x4 acc[2][2][4][2];
#pragma unroll
    for (int a = 0; a < 2; ++a)
#pragma unroll
        for (int b = 0; b < 2; ++b)
#pragma unroll
            for (int m = 0; m < 4; ++m)
#pragma unroll
                for (int n = 0; n < 2; ++n) acc[a][b][m][n] = (f32x4){0.f, 0.f, 0.f, 0.f};
    bf16x8 At[4][2], B0[2][2], B1[2][2];
    GAS const char* cA = (GAS const char*)g.A + (size_t)cur.pm * tstepA; GAS const char* cB = (GAS const char*)g.Bt + (size_t)cur.pn * tstepB;
    PG8_STAGE(PG8_SB(0, 0), cB, voffB); PG8_STAGE(PG8_SB(0, 1), cB + hstepB, voffB); PG8_STAGE(PG8_SA(0, 0), cA, voffA); PG8_STAGE(PG8_SA(0, 1), cA + hstepA, voffA);
    if (wr == 1) PG8_BAR;
    PG8_WAIT_V(2); PG8_BAR;
    PG8_STAGE(PG8_SB(1, 0), cB + kstep, voffB); PG8_STAGE(PG8_SA(1, 0), cA + kstep, voffA); PG8_STAGE(PG8_SB(1, 1), cB + hstepB + kstep, voffB);
    PG8_WAIT_V(6); PG8_BAR;
    for (;;) {
        const bool has_next = S.next(ui + 1, nxt);
        GAS const char* nA = has_next ? (GAS const char*)g.A + (size_t)nxt.pm * tstepA : cA; GAS const char* nB = has_next ? (GAS const char*)g.Bt + (size_t)nxt.pn * tstepB : cB;
        for (int t = 0; t < nt; t += 2) {
            const bool last = (t == nt - 2);
            GAS const char* a1 = cA + (size_t)(t + 1) * kstep;
            GAS const char* a2 = last ? nA : cA + (size_t)(t + 2) * kstep; GAS const char* b2 = last ? nB : cB + (size_t)(t + 2) * kstep;
            GAS const char* a3 = a2 + kstep; GAS const char* b3 = b2 + kstep;
            PG8_LDB(B0, 0, 0); PG8_LDB(B1, 0, 1); PG8_SCHED; PG8_LDA(At, 0, 0); PG8_STAGE(PG8_SA(1, 1), a1 + hstepA, voffA);
            PG8_WAIT_V(8); PG8_WAIT_L(0); PG8_BAR; PG8_MMA(0, 0, At, B0); PG8_MMA(0, 1, At, B1); PG8_BAR; PG8_SCHED;
            PG8_LDA(At, 0, 1); PG8_STAGE(PG8_SB(0, 0), b2, voffB); PG8_STAGE(PG8_SB(0, 1), b2 + hstepB, voffB); PG8_STAGE(PG8_SA(0, 0), a2, voffA);
            PG8_WAIT_V(8); PG8_WAIT_L(0); PG8_BAR; PG8_MMA(1, 0, At, B0); PG8_MMA(1, 1, At, B1); PG8_BAR; PG8_SCHED;
            PG8_LDB(B0, 1, 0); PG8_LDB(B1, 1, 1); PG8_SCHED; PG8_LDA(At, 1, 0); PG8_STAGE(PG8_SA(0, 1), a2 + hstepA, voffA);
            PG8_WAIT_V(8); PG8_WAIT_L(0); PG8_BAR; PG8_MMA(0, 0, At, B0); PG8_MMA(0, 1, At, B1); PG8_BAR; PG8_SCHED;
            PG8_LDA(At, 1, 1); PG8_STAGE(PG8_SB(1, 0), b3, voffB); PG8_STAGE(PG8_SB(1, 1), b3 + hstepB, voffB); PG8_STAGE(PG8_SA(1, 0), a3, voffA);
            PG8_WAIT_V(8); PG8_WAIT_L(0); PG8_BAR; PG8_MMA(1, 0, At, B0); PG8_MMA(1, 1, At, B1); PG8_BAR; PG8_SCHED;
        }
        if (wr == 0) PG8_BAR;
        E(acc, cur, wr, wc, fr, fq);
        if (!has_next) break;
#pragma unroll
        for (int a = 0; a < 2; ++a)
#pragma unroll
            for (int b = 0; b < 2; ++b)
#pragma unroll
                for (int m = 0; m < 4; ++m)
#pragma unroll
                    for (int n = 0; n < 2; ++n) acc[a][b][m][n] = (f32x4){0.f, 0.f, 0.f, 0.f};
        cur = nxt; cA = nA; cB = nB; ++ui;
        if (wr == 1) PG8_BAR;
    }
    PG8_WAIT_V(0);
    PG8_BAR;
#undef PG8_SA
#undef PG8_SB
#undef PG8_STAGE
#undef PG8_LDA
#undef PG8_LDB
#undef PG8_MMA
#undef PG8_WAIT_V
#undef PG8_WAIT_L
#undef PG8_BAR
#undef PG8_SCHED
}

typedef const f32x4 (&AccRef)[2][2][4][2];

struct EpiSwiglu {
    static constexpr bool PERM = true;
    GAS bf16_t* O;
    __device__ __forceinline__ void operator()(AccRef acc, const Unit& u, int wr, int wc, int fr, int fq) const {
        const int row0 = u.pm * BM + wr * 64 + fr, col0 = u.pn * HALF + wc * 32 + 8 * fq;
#pragma unroll
        for (int ai = 0; ai < 2; ++ai)
#pragma unroll
            for (int m = 0; m < 4; ++m) {
                GAS bf16_t* rowp = O + (size_t)(row0 + ai * HALF + m * 16) * DFF + col0;
                const f32x4 g0 = acc[ai][0][m][0], g1 = acc[ai][0][m][1], u0 = acc[ai][1][m][0], u1 = acc[ai][1][m][1];
                u32x4 w;
                w.x = cvt_pk_bf16(siluf_(g0[0]) * u0[0], siluf_(g0[1]) * u0[1]); w.y = cvt_pk_bf16(siluf_(g0[2]) * u0[2], siluf_(g0[3]) * u0[3]);
                w.z = cvt_pk_bf16(siluf_(g1[0]) * u1[0], siluf_(g1[1]) * u1[1]); w.w = cvt_pk_bf16(siluf_(g1[2]) * u1[2], siluf_(g1[3]) * u1[3]);
                *(GAS u32x4*)rowp = w;
            }
    }
};

struct EpiY {
    static constexpr bool PERM = true;
    GAS bf16_t* Y; GAS const float* gate; float coef;
    __device__ __forceinline__ void operator()(AccRef acc, const Unit& u, int wr, int wc, int fr, int fq) const {
        const int row0 = u.pm * BM + wr * 64 + fr, col0 = u.pn * BM + wc * 32 + 8 * fq;
        GAS const float* gp = gate + (size_t)(u.pm >> 4) * NADA + col0;
        f32x4 gv[2][2];
#pragma unroll
        for (int bj = 0; bj < 2; ++bj)
#pragma unroll
            for (int n = 0; n < 2; ++n) gv[bj][n] = *(GAS const f32x4*)(gp + bj * HALF + n * 4) * coef;
#pragma unroll
        for (int ai = 0; ai < 2; ++ai)
#pragma unroll
            for (int m = 0; m < 4; ++m) {
                GAS bf16_t* rowp = Y + (size_t)(row0 + ai * HALF + m * 16) * D + col0;
#pragma unroll
                for (int bj = 0; bj < 2; ++bj) {
                    const f32x4 v0 = acc[ai][bj][m][0] * gv[bj][0], v1 = acc[ai][bj][m][1] * gv[bj][1];
                    u32x4 w; w.x = cvt_pk_bf16(v0[0], v0[1]); w.y = cvt_pk_bf16(v0[2], v0[3]); w.z = cvt_pk_bf16(v1[0], v1[1]); w.w = cvt_pk_bf16(v1[2], v1[3]);
                    *(GAS u32x4*)(rowp + bj * HALF) = w;
                }
            }
    }
};

struct EpiZ {
    static constexpr bool PERM = true;
    GAS bf16_t* Z;
    __device__ __forceinline__ void operator()(AccRef acc, const Unit& u, int wr, int wc, int fr, int fq) const {
        const int row0 = u.pm * BM + wr * 64 + fr, col0 = u.pn * BM + wc * 32 + 8 * fq;
        const bool sg = u.pn >= 7;
#pragma unroll
        for (int ai = 0; ai < 2; ++ai)
#pragma unroll
            for (int m = 0; m < 4; ++m) {
                GAS bf16_t* rowp = Z + (size_t)(row0 + ai * HALF + m * 16) * NZ + col0;
#pragma unroll
                for (int bj = 0; bj < 2; ++bj) {
                    f32x4 v0 = acc[ai][bj][m][0], v1 = acc[ai][bj][m][1];
                    if (sg) {
#pragma unroll
                        for (int j = 0; j < 4; ++j) { v0[j] = sigmoidf_(v0[j]); v1[j] = sigmoidf_(v1[j]); }
                    }
                    u32x4 w; w.x = cvt_pk_bf16(v0[0], v0[1]); w.y = cvt_pk_bf16(v0[2], v0[3]); w.z = cvt_pk_bf16(v1[0], v1[1]); w.w = cvt_pk_bf16(v1[2], v1[3]);
                    *(GAS u32x4*)(rowp + bj * HALF) = w;
                }
            }
    }
};

struct EpiGate {
    static constexpr bool PERM = true;
    GAS const bf16_t* Z; GAS bf16_t* MX; int goff; int add;
    __device__ __forceinline__ void operator()(AccRef acc, const Unit& u, int wr, int wc, int fr, int fq) const {
        const int row0 = u.pm * BM + wr * 64 + fr, col0 = u.pn * BM + wc * 32 + 8 * fq;
#pragma unroll
        for (int ai = 0; ai < 2; ++ai)
#pragma unroll
            for (int m = 0; m < 4; ++m) {
                const size_t row = (size_t)(row0 + ai * HALF + m * 16);
#pragma unroll
                for (int bj = 0; bj < 2; ++bj) {
                    const u32x4 gz = *(GAS const u32x4*)(Z + row * NZ + goff + col0 + bj * HALF);
                    GAS bf16_t* op = MX + row * D + col0 + bj * HALF;
                    const f32x4 v0 = acc[ai][bj][m][0], v1 = acc[ai][bj][m][1];
                    float r[8];
                    r[0] = bf_lo(gz.x) * v0[0]; r[1] = bf_hi(gz.x) * v0[1]; r[2] = bf_lo(gz.y) * v0[2]; r[3] = bf_hi(gz.y) * v0[3];
                    r[4] = bf_lo(gz.z) * v1[0]; r[5] = bf_hi(gz.z) * v1[1]; r[6] = bf_lo(gz.w) * v1[2]; r[7] = bf_hi(gz.w) * v1[3];
                    if (add) { const u32x4 pv = *(GAS const u32x4*)op;
                        r[0] += bf_lo(pv.x); r[1] += bf_hi(pv.x); r[2] += bf_lo(pv.y); r[3] += bf_hi(pv.y); r[4] += bf_lo(pv.z); r[5] += bf_hi(pv.z); r[6] += bf_lo(pv.w); r[7] += bf_hi(pv.w); }
                    u32x4 w; w.x = cvt_pk_bf16(r[0], r[1]); w.y = cvt_pk_bf16(r[2], r[3]); w.z = cvt_pk_bf16(r[4], r[5]); w.w = cvt_pk_bf16(r[6], r[7]);
                    *(GAS u32x4*)op = w;
                }
            }
    }
};

struct EpiCmp1 {
    static constexpr bool PERM = true;
    GAS bf16_t* Hd;
    __device__ __forceinline__ void operator()(AccRef acc, const Unit& u, int wr, int wc, int fr, int fq) const {
        const int row0 = u.pm * BM + wr * 64 + fr, col0 = wc * 32 + 8 * fq;
#pragma unroll
        for (int ai = 0; ai < 2; ++ai)
#pragma unroll
            for (int m = 0; m < 4; ++m) {
                GAS bf16_t* rowp = Hd + (size_t)(row0 + ai * HALF + m * 16) * 256 + col0;
#pragma unroll
                for (int bj = 0; bj < 2; ++bj) {
                    const f32x4 v0 = acc[ai][bj][m][0], v1 = acc[ai][bj][m][1];
                    u32x4 w; w.x = cvt_pk_bf16(gelu_tanh(v0[0]), gelu_tanh(v0[1])); w.y = cvt_pk_bf16(gelu_tanh(v0[2]), gelu_tanh(v0[3]));
                    w.z = cvt_pk_bf16(gelu_tanh(v1[0]), gelu_tanh(v1[1])); w.w = cvt_pk_bf16(gelu_tanh(v1[2]), gelu_tanh(v1[3]));
                    *(GAS u32x4*)(rowp + bj * HALF) = w;
                }
            }
    }
};

struct EpiCmp2 {
    static constexpr bool PERM = true;
    GAS bf16_t* out; int tr;
    __device__ __forceinline__ void operator()(AccRef acc, const Unit& u, int wr, int wc, int fr, int fq) const {
        if (wc >= 2) return;
        const int row0 = u.pm * BM + wr * 64 + fr, col0 = wc * 32 + 8 * fq;
#pragma unroll
        for (int ai = 0; ai < 2; ++ai)
#pragma unroll
            for (int m = 0; m < 4; ++m) {
                const int row = row0 + ai * HALF + m * 16;
                const f32x4 v0 = acc[ai][0][m][0], v1 = acc[ai][0][m][1];
                u32x4 w; w.x = cvt_pk_bf16(v0[0], v0[1]); w.y = cvt_pk_bf16(v0[2], v0[3]); w.z = cvt_pk_bf16(v1[0], v1[1]); w.w = cvt_pk_bf16(v1[2], v1[3]);
                if (!tr) { *(GAS u32x4*)(out + (size_t)row * 64 + col0) = w; }
                else {
                    GAS bf16_t* base = out + ((size_t)(row >> 8) * 64 + col0) * 256 + (row & 255);
                    base[0 * 256] = (bf16_t)(w.x & 0xffffu); base[1 * 256] = (bf16_t)(w.x >> 16); base[2 * 256] = (bf16_t)(w.y & 0xffffu); base[3 * 256] = (bf16_t)(w.y >> 16);
                    base[4 * 256] = (bf16_t)(w.z & 0xffffu); base[5 * 256] = (bf16_t)(w.z >> 16); base[6 * 256] = (bf16_t)(w.w & 0xffffu); base[7 * 256] = (bf16_t)(w.w >> 16);
                }
            }
    }
};
}

__device__ __forceinline__ float wave_sum(float v) {
#pragma unroll
    for (int o = 1; o < 64; o <<= 1) v += __shfl_xor(v, o);
    return v;
}

__device__ __forceinline__ void tr_item(GAS const float* __restrict__ W, int N, GAS bf16_t* WT, int ldd, int map, LAS float* scr, int item, int nblk, int lane) {
    const int kb = item / nblk, nb = item % nblk, k0 = 64 * kb, n0 = 32 * nb;
    const int nd = n0 + (lane & 31);
    int sc;
    if (map == 0) sc = nd;
    else if (map == 1) { const int t = nd >> 8, r = nd & 255; sc = r < 128 ? 128 * t + r : DFF + 128 * t + (r - 128); }
    else if (map == 2) sc = nd < 1816 ? nd : (nd < 2048 ? -1 : nd - 232);
    else sc = nd < 64 ? nd : -1;
    const int scl = sc >= 0 ? sc : 0;
    float wv[32];
#pragma unroll
    for (int i = 0; i < 32; ++i) wv[i] = W[(size_t)(k0 + 2 * i + (lane >> 5)) * N + scl];
#pragma unroll
    for (int i = 0; i < 32; ++i) { const int kk = 2 * i + (lane >> 5); scr[kk * 33 + (lane & 31)] = sc >= 0 ? wv[i] : 0.f; }
    LDS_WAIT(); asm volatile("" ::: "memory");
    const int c = lane & 7;
#pragma unroll
    for (int j = 0; j < 4; ++j) { const int n = (lane >> 3) + 8 * j; const LAS float* s = scr + (8 * c) * 33 + n;
        u32x4 o; o.x = cvt_pk_bf16(s[0 * 33], s[1 * 33]); o.y = cvt_pk_bf16(s[2 * 33], s[3 * 33]); o.z = cvt_pk_bf16(s[4 * 33], s[5 * 33]); o.w = cvt_pk_bf16(s[6 * 33], s[7 * 33]);
        *(GAS u32x4*)(WT + (size_t)(n0 + n) * ldd + k0 + 8 * c) = o; }
    LDS_WAIT(); asm volatile("" ::: "memory");
}

template <bool WRITE_X, bool WRITE_H, bool ADD_Y, bool PRE_LN, bool SRC_BF16, bool X_BF16>
__device__ __forceinline__ void ln_rows(GAS const void* srcv, GAS const bf16_t* Y, GAS void* Xv, GAS bf16_t* H, GAS const float* __restrict__ lg, GAS const float* __restrict__ lb, GAS const float* ada, int modi,
                                        GAS const float* __restrict__ pg, GAS const float* __restrict__ pb, int gw, int NGW, int lane) {
    for (int row0 = 2 * gw; row0 < M; row0 += 2 * NGW) {
        f32x4 v[2][4]; u32x2 yv[2][4];
#pragma unroll
        for (int rr = 0; rr < 2; ++rr) {
            const int row = row0 + rr;
#pragma unroll
            for (int j = 0; j < 4; ++j) {
                if (SRC_BF16) { const u32x2 xb = ((GAS const u32x2*)((GAS const bf16_t*)srcv + (size_t)row * D) + lane)[64 * j]; v[rr][j] = (f32x4){bf_lo(xb.x), bf_hi(xb.x), bf_lo(xb.y), bf_hi(xb.y)}; }
                else v[rr][j] = ((GAS const f32x4*)((GAS const float*)srcv + (size_t)row * D) + lane)[64 * j];
                if (ADD_Y) yv[rr][j] = ((GAS const u32x2*)(Y + (size_t)row * D) + lane)[64 * j];
            }
        }
#pragma unroll
        for (int rr = 0; rr < 2; ++rr) {
            const int row = row0 + rr;
            if (PRE_LN) {
                float s = 0.f;
#pragma unroll
                for (int j = 0; j < 4; ++j) s += (v[rr][j].x + v[rr][j].y) + (v[rr][j].z + v[rr][j].w);
                const float mean = wave_sum(s) * (1.f / D); float s2 = 0.f;
#pragma unroll
                for (int j = 0; j < 4; ++j) { v[rr][j] = v[rr][j] - mean; s2 += (v[rr][j].x * v[rr][j].x + v[rr][j].y * v[rr][j].y) + (v[rr][j].z * v[rr][j].z + v[rr][j].w * v[rr][j].w); }
                const float rstd = 1.f / sqrtf(wave_sum(s2) * (1.f / D) + LN_EPS);
#pragma unroll
                for (int j = 0; j < 4; ++j) { const int col = 4 * lane + 256 * j; v[rr][j] = v[rr][j] * rstd * *(GAS const f32x4*)(pg + col) + *(GAS const f32x4*)(pb + col); }
            }
            float s = 0.f;
#pragma unroll
            for (int j = 0; j < 4; ++j) {
                if (ADD_Y) { const u32x2 y = yv[rr][j]; v[rr][j] = v[rr][j] * ALPHA + (f32x4){bf_lo(y.x), bf_hi(y.x), bf_lo(y.y), bf_hi(y.y)}; }
                s += (v[rr][j].x + v[rr][j].y) + (v[rr][j].z + v[rr][j].w);
            }
            const float mean = wave_sum(s) * (1.f / D); float s2 = 0.f;
#pragma unroll
            for (int j = 0; j < 4; ++j) { v[rr][j] = v[rr][j] - mean; s2 += (v[rr][j].x * v[rr][j].x + v[rr][j].y * v[rr][j].y) + (v[rr][j].z * v[rr][j].z + v[rr][j].w * v[rr][j].w); }
            const float rstd = 1.f / sqrtf(wave_sum(s2) * (1.f / D) + LN_EPS);
            GAS const float* ab = ada + (size_t)(row >> 12) * NADA + (size_t)modi * 3 * D;
            GAS u32x2* ho = (GAS u32x2*)(H + (size_t)row * D) + lane;
#pragma unroll
            for (int j = 0; j < 4; ++j) {
                const int col = 4 * lane + 256 * j;
                const f32x4 gg = *(GAS const f32x4*)(lg + col), bb = *(GAS const f32x4*)(lb + col);
                const f32x4 y = v[rr][j] * rstd * gg + bb;
                if (WRITE_X) {
                    if (X_BF16) { u32x2 w; w.x = cvt_pk_bf16(y.x, y.y); w.y = cvt_pk_bf16(y.z, y.w); ((GAS u32x2*)((GAS bf16_t*)Xv + (size_t)row * D) + lane)[64 * j] = w; }
                    else ((GAS f32x4*)((GAS float*)Xv + (size_t)row * D) + lane)[64 * j] = y;
                }
                if (WRITE_H) {
                    const f32x4 sh = *(GAS const f32x4*)(ab + col), sc = *(GAS const f32x4*)(ab + D + col);
                    const f32x4 h = y * (sc + 1.0f) + sh;
                    u32x2 w; w.x = cvt_pk_bf16(h.x, h.y); w.y = cvt_pk_bf16(h.z, h.w);
                    ho[64 * j] = w;
                }
            }
        }
    }
}

namespace att {
constexpr int SLOT_BYTES = 16384, NSLOT = 3;
constexpr int OFF_IMP = NSLOT * SLOT_BYTES;
constexpr int IMP_PITCH = 65;
constexpr int OFF_SCORE = OFF_IMP + 4 * 64 * IMP_PITCH * 4;
constexpr int OFF_SEL = OFF_SCORE + 64 * IMP_PITCH * 4;
constexpr int OFF_UN = OFF_SEL + 512;
constexpr int OFF_LIST = OFF_UN + 16;
constexpr float NEGV = -1e30f;
constexpr float C2 = 0.125f * LOG2E;

struct Src { GAS const bf16_t* k; GAS const bf16_t* v; int kpitch, vpitch; };

template <int MODE, bool INTERIOR>
__device__ __forceinline__ void tile_compute(const LAS unsigned char* Kb, const LAS unsigned char* Vb, const bf16x8 (&qf)[4], f32x16 (&o)[2], float& m, float& l, float inv_l,
                                             int tile, int t, float slope2, bool selbit, int qb, int ql, int hh, float (&prim)[8], float& carry) {
    const int swz4 = ((ql >> 1) & 7) << 4;
    bf16x8 kf[4][2];
#pragma unroll
    for (int ds = 0; ds < 4; ++ds) {
        kf[ds][0] = *(const LAS bf16x8*)(Kb + ql * 128 + (((ds * 2 + hh) << 4) ^ swz4));
        kf[ds][1] = *(const LAS bf16x8*)(Kb + (32 + ql) * 128 + (((ds * 2 + hh) << 4) ^ swz4));
    }
    __builtin_amdgcn_sched_barrier(0);
    f32x16 s[2];
    if (INTERIOR) {
        const float slopeC = slope2 * (1.0f / C2) * (MODE <= 1 ? 16.f : 1.f);
        float b0C = (MODE <= 1) ? slope2 * (1.0f / C2) * (float)(16 * (tile * 64 + 4 * hh) + 31 - t) : slopeC * (float)(tile * 64 + 4 * hh - t);
        if (MODE == 2 && !selbit) b0C = NEGV;
#pragma unroll
        for (int sub = 0; sub < 2; ++sub)
#pragma unroll
            for (int i = 0; i < 16; ++i) s[sub][i] = __builtin_fmaf(slopeC, (float)(sub * 32 + (i & 3) + 8 * (i >> 2)), b0C);
    } else {
#pragma unroll
        for (int i = 0; i < 16; ++i) { s[0][i] = 0.f; s[1][i] = 0.f; }
    }
#pragma unroll
    for (int ds = 0; ds < 4; ++ds) {
        s[0] = __builtin_amdgcn_mfma_f32_32x32x16_bf16(kf[ds][0], qf[ds], s[0], 0, 0, 0);
        s[1] = __builtin_amdgcn_mfma_f32_32x32x16_bf16(kf[ds][1], qf[ds], s[1], 0, 0, 0);
    }
    constexpr bool VPRE = INTERIOR && MODE >= 2;
    u32x2 vlo[4][2], vhi[4][2];
    if (VPRE) {
#pragma unroll
        for (int ks = 0; ks < 4; ++ks)
#pragma unroll
            for (int dsub = 0; dsub < 2; ++dsub) {
                const LAS unsigned char* vrow = Vb + (dsub * 32 + ql) * 128 + hh * 8;
                vlo[ks][dsub] = *(const LAS u32x2*)(vrow + (((ks * 2) << 4) ^ swz4)); vhi[ks][dsub] = *(const LAS u32x2*)(vrow + (((ks * 2 + 1) << 4) ^ swz4));
            }
        __builtin_amdgcn_sched_barrier(0);
    }
    float mx = NEGV;
    if (INTERIOR) {
#pragma unroll
        for (int sub = 0; sub < 2; ++sub)
#pragma unroll
            for (int i = 0; i < 16; ++i) { const float sv = s[sub][i] * C2; s[sub][i] = sv; mx = fmaxf(mx, sv); }
    } else {
        __builtin_amdgcn_sched_barrier(0);
        const float base = (MODE <= 1) ? (float)(t - 31 - 16 * (tile * 64 + 4 * hh)) : (float)(t - tile * 64 - 4 * hh);
        const float step = (MODE <= 1) ? 16.f : 1.f;
        const float nslope = -slope2;
#pragma unroll
        for (int sub = 0; sub < 2; ++sub)
#pragma unroll
            for (int i = 0; i < 16; ++i) {
                const float cpos = (float)(sub * 32 + (i & 3) + 8 * (i >> 2));
                const float dist = base - step * cpos;
                bool valid = dist >= 0.f;
                if (MODE == 2) valid = valid && selbit;
                if (MODE == 3) valid = valid && dist < 512.f;
                const float sv = valid ? __builtin_fmaf(s[sub][i], C2, nslope * dist) : NEGV;
                s[sub][i] = sv; mx = fmaxf(mx, sv);
            }
    }
    if (MODE != 1) {
        mx = fmaxf(mx, __shfl_xor(mx, 32));
        const float mn = fmaxf(m, mx);
        float rs = 0.f;
#pragma unroll
        for (int sub = 0; sub < 2; ++sub)
#pragma unroll
            for (int i = 0; i < 16; ++i) { const float sv = s[sub][i]; const float p = INTERIOR ? fast_exp2(sv - mn) : (sv > -1e29f ? fast_exp2(sv - mn) : 0.f); s[sub][i] = p; rs += p; }
        rs += __shfl_xor(rs, 32);
        if (__builtin_amdgcn_ballot_w64(mn > m) != 0ull) {
            const float alpha = fast_exp2(m - mn);
            l *= alpha;
            if (MODE != 0) {
#pragma unroll
                for (int i = 0; i < 16; ++i) { o[0][i] *= alpha; o[1][i] *= alpha; }
            }
        }
        l += rs; m = mn;
    } else {
#pragma unroll
        for (int sub = 0; sub < 2; ++sub)
#pragma unroll
            for (int i = 0; i < 16; ++i) { const float sv = s[sub][i]; s[sub][i] = (INTERIOR || sv > -1e29f) ? fast_exp2(sv - m) * inv_l : 0.f; }
        float sp[8];
#pragma unroll
        for (int k = 0; k < 8; ++k) { const int sub = k >> 2, i0 = (k & 3) * 4; prim[k] = (s[sub][i0] + s[sub][i0 + 1]) + (s[sub][i0 + 2] + s[sub][i0 + 3]); sp[k] = s[sub][i0 + 3]; }
        float x[8];
#pragma unroll
        for (int k = 0; k < 8; ++k) x[k] = __shfl_xor(sp[k], 32);
#pragma unroll
        for (int k = 0; k < 8; ++k) { const float fromlow = (k > 0) ? x[k > 0 ? k - 1 : 0] : carry; prim[k] += hh ? x[k] : fromlow; }
        carry = x[7];
    }
    if (MODE != 0) {
#pragma unroll
        for (int ks = 0; ks < 4; ++ks) {
            const int sub = ks >> 1, i0 = (ks & 1) * 8;
            union { u32x4 u; bf16x8 b; } pk;
            pk.u.x = cvt_pk_bf16(s[sub][i0 + 0], s[sub][i0 + 1]); pk.u.y = cvt_pk_bf16(s[sub][i0 + 2], s[sub][i0 + 3]);
            pk.u.z = cvt_pk_bf16(s[sub][i0 + 4], s[sub][i0 + 5]); pk.u.w = cvt_pk_bf16(s[sub][i0 + 6], s[sub][i0 + 7]);
#pragma unroll
            for (int dsub = 0; dsub < 2; ++dsub) {
                union { u32x4 u; bf16x8 b; } vf;
                const LAS unsigned char* vrow2 = Vb + (dsub * 32 + ql) * 128 + hh * 8;
                const u32x2 lo = VPRE ? vlo[ks][dsub] : *(const LAS u32x2*)(vrow2 + (((ks * 2) << 4) ^ swz4)), hi = VPRE ? vhi[ks][dsub] : *(const LAS u32x2*)(vrow2 + (((ks * 2 + 1) << 4) ^ swz4));
                vf.u.x = lo.x; vf.u.y = lo.y; vf.u.z = hi.x; vf.u.w = hi.y;
                o[dsub] = __builtin_amdgcn_mfma_f32_32x32x16_bf16(vf.b, pk.b, o[dsub], 0, 0, 0);
            }
        }
    }
}

__device__ __forceinline__ void attn_phase(LAS unsigned char* lds, GAS const bf16_t* Z, GAS const bf16_t* vTs, GAS const bf16_t* vTw, GAS const bf16_t* kc, GAS const bf16_t* vcT, GAS bf16_t* O, int G, int bid) {
    LAS float* imp = (LAS float*)(lds + OFF_IMP);
    LAS float* score = (LAS float*)(lds + OFF_SCORE);
    LAS unsigned char* selb = lds + OFF_SEL;
    LAS unsigned* un = (LAS unsigned*)(lds + OFF_UN);
    LAS unsigned short* tlist = (LAS unsigned short*)(lds + OFF_LIST);
    int cnt = 0;
#define ATT_ISSUE(desc_, k_) do { const int kd_ = (desc_) >> 8, tl_ = (desc_) & 255; \
        GAS const bf16_t* kg_; GAS const bf16_t* vg_; \
        if (kd_ <= 1) { kg_ = kc + ((size_t)bg * 256 + tl_ * 64) * 64 + okc; vg_ = vcT + (size_t)bg * 64 * 256 + tl_ * 64 + ovc; } \
        else if (kd_ <= 3) { kg_ = Z + ((size_t)b * SEQ + tl_ * 64) * NZ + ZC_KSLC + g * 64 + okz; vg_ = vTs + (size_t)bg * 64 * SEQ + tl_ * 64 + ovt; } \
        else { kg_ = Z + ((size_t)b * SEQ + tl_ * 64) * NZ + ZC_KWIN + g * 64 + okz; vg_ = vTw + (size_t)bg * 64 * SEQ + tl_ * 64 + ovt; } \
        LAS unsigned char* sl_ = lds + ((k_) % 3) * SLOT_BYTES + wave * 1024; \
        __builtin_amdgcn_global_load_lds((GAS const unsigned*)kg_, (LAS unsigned*)sl_, 16, 0, 0); \
        __builtin_amdgcn_global_load_lds((GAS const unsigned*)vg_, (LAS unsigned*)(sl_ + 8192), 16, 0, 0); } while (0)
    for (int uidx = bid; uidx < 2048; uidx += G) {
        int tid = threadIdx.x; asm volatile("" : "+v"(tid));
        const int wave = __builtin_amdgcn_readfirstlane(tid >> 6), lane = tid & 63;
        const int hg = wave >> 1, qh = wave & 1, ql = lane & 31, hh = lane >> 5;
        const int qrow = qh * 32 + ql;
        const int kk = uidx >> 8, bb = uidx & 255, r = bb >> 5, bg = (bb & 31) ^ (((kk + 1) >> 1) & 1);
        const int qb = 63 - 8 * kk - ((kk & 1) ? (7 - r) : r);
        const int b = bg >> 1, g = bg & 1;
        const int head = g * 4 + hg;
        const float slope2 = exp2f(-(float)(head + 1)) * LOG2E;
        const int t = qb * 64 + qrow;
        const size_t token = (size_t)b * SEQ + t;
        const int lrow = wave * 8 + (lane >> 3), cfetch = (lane & 7) ^ ((lrow >> 1) & 7);
        const int okc = lrow * 64 + cfetch * 8, ovc = lrow * 256 + cfetch * 8, okz = lrow * NZ + cfetch * 8, ovt = lrow * SEQ + cfetch * 8;
        if (tid < 2) un[tid] = 0u;
        bf16x8 qf[4];
#pragma unroll
        for (int ds = 0; ds < 4; ++ds) qf[ds] = *(GAS const bf16x8*)(Z + token * NZ + ZC_Q + head * 64 + ds * 16 + hh * 8);
        f32x16 o[2];
        LAS float* outst = (LAS float*)(lds + OFF_IMP) + wave * 2048 + lane;
        float prim[8]; float carry = 0.f;
        GAS const bf16_t* gzp = Z + token * NZ + ZC_GNSA + head * 3;
        const float gate0 = __uint_as_float((unsigned)gzp[0] << 16), gate1 = __uint_as_float((unsigned)gzp[1] << 16), gate2 = __uint_as_float((unsigned)gzp[2] << 16);
        float m = NEGV, l = 0.f, inv_l = 0.f;
        const int ntc = (qb >> 4) + 1, nA = 2 * ntc;
#define DESC_A(i_) ((i_) < ntc ? (i_) : (0x100 | ((i_) - ntc)))
        ATT_ISSUE(DESC_A(0), cnt); ATT_ISSUE(DESC_A(1), cnt + 1);
        for (int i = 0; i < nA; ++i) {
            if (i + 1 < nA) asm volatile("s_waitcnt vmcnt(2)" ::: "memory"); else asm volatile("s_waitcnt vmcnt(0)" ::: "memory");
            __builtin_amdgcn_s_barrier(); asm volatile("" ::: "memory");
            if (i + 2 < nA) ATT_ISSUE(DESC_A(i + 2), cnt + 2);
            const LAS unsigned char* Kb = lds + (cnt % 3) * SLOT_BYTES; const LAS unsigned char* Vb = Kb + 8192;
            if (i < ntc) {
                if (1024 * i + 1039 <= 64 * qb) tile_compute<0, true>(Kb, Vb, qf, o, m, l, 0.f, i, t, slope2, true, qb, ql, hh, prim, carry);
                else tile_compute<0, false>(Kb, Vb, qf, o, m, l, 0.f, i, t, slope2, true, qb, ql, hh, prim, carry);
            } else {
                const int tc = i - ntc;
                if (tc == 0) {
                    inv_l = l > 0.f ? 1.0f / l : 0.f;
#pragma unroll
                    for (int e = 0; e < 16; ++e) { o[0][e] = 0.f; o[1][e] = 0.f; }
                }
                if (1024 * tc + 1039 <= 64 * qb) tile_compute<1, true>(Kb, Vb, qf, o, m, l, inv_l, tc, t, slope2, true, qb, ql, hh, prim, carry);
                else tile_compute<1, false>(Kb, Vb, qf, o, m, l, inv_l, tc, t, slope2, true, qb, ql, hh, prim, carry);
#pragma unroll
                for (int k = 0; k < 8; ++k) imp[(hg * 64 + qrow) * IMP_PITCH + tc * 16 + 2 * k + hh] = prim[k];
            }
            ++cnt;
        }
        __syncthreads();
        int tid2 = threadIdx.x; asm volatile("" : "+v"(tid2));
#pragma unroll
        for (int i = 0; i < 8; ++i) {
            const int idx = tid2 + 512 * i, q = idx >> 6, j = idx & 63;
            float sc;
            if (j > qb) sc = NEGV;
            else if (j == 0 || j == qb || j == qb - 1) sc = 1e9f;
            else sc = ((imp[(0 * 64 + q) * IMP_PITCH + j] + imp[(1 * 64 + q) * IMP_PITCH + j]) + imp[(2 * 64 + q) * IMP_PITCH + j]) + imp[(3 * 64 + q) * IMP_PITCH + j];
            score[q * IMP_PITCH + j] = sc;
        }
        __syncthreads();
        {
            const int q = tid2 >> 3, jb = tid2 & 7;
            unsigned long long ownk[8]; int rank[8];
#pragma unroll
            for (int e = 0; e < 8; ++e) { const float sv = score[q * IMP_PITCH + jb * 8 + e]; const unsigned u = sv > 0.f ? __float_as_uint(sv) : 0u; ownk[e] = ((unsigned long long)u << 6) | (unsigned)(63 - (jb * 8 + e)); rank[e] = 0; }
#pragma unroll 4
            for (int j2 = 0; j2 <= qb; ++j2) {
                const float v = score[q * IMP_PITCH + j2];
                const unsigned u = v > 0.f ? __float_as_uint(v) : 0u;
                const unsigned long long kj = ((unsigned long long)u << 6) | (unsigned)(63 - j2);
#pragma unroll
                for (int e = 0; e < 8; ++e) rank[e] += (kj > ownk[e]) ? 1 : 0;
            }
            unsigned byte = 0;
#pragma unroll
            for (int e = 0; e < 8; ++e) byte |= (rank[e] < 16 ? 1u : 0u) << e;
            selb[q * 8 + jb] = (unsigned char)byte;
            atomicOr((unsigned*)(un + (jb >> 2)), byte << (8 * (jb & 3)));
        }
        __syncthreads();
#pragma unroll
        for (int i = 0; i < 16; ++i) { outst[i * 64] = gate0 * o[0][i]; outst[(16 + i) * 64] = gate0 * o[1][i]; }
        const u32x2 selw = *(const LAS u32x2*)(selb + qrow * 8);
        const unsigned long long selmask = ((unsigned long long)selw.y << 32) | selw.x;
        unsigned long long unmask = ((unsigned long long)un[1] << 32) | un[0];
        unmask &= (qb >= 63) ? ~0ull : ((1ull << (qb + 1)) - 1ull);
        const int nslc = (int)__builtin_popcountll(unmask);
        const int j0 = qb >= 8 ? qb - 8 : 0;
        const int nB = nslc + (qb - j0 + 1);
        if (tid2 < 64) { if ((unmask >> tid2) & 1ull) { const int pos = (tid2 >= 63) ? 0 : (int)__builtin_popcountll(unmask >> (tid2 + 1)); tlist[pos] = (unsigned short)(((tid2 == qb) ? 0x300 : 0x200) | tid2); } }
        else if (tid2 < 73) { const int w = tid2 - 64, j = qb - w; if (j >= j0) tlist[nslc + w] = (unsigned short)(((j == qb || j == qb - 8) ? 0x500 : 0x400) | j); }
        __syncthreads();
#define DESC_B(i_) ((int)__builtin_amdgcn_readfirstlane((unsigned)tlist[(i_)]))
        m = NEGV; l = 0.f;
#pragma unroll
        for (int e = 0; e < 16; ++e) { o[0][e] = 0.f; o[1][e] = 0.f; }
        ATT_ISSUE(DESC_B(0), cnt); ATT_ISSUE(DESC_B(1), cnt + 1);
        for (int i = 0; i < nB; ++i) {
            if (i + 1 < nB) asm volatile("s_waitcnt vmcnt(2)" ::: "memory"); else asm volatile("s_waitcnt vmcnt(0)" ::: "memory");
            __builtin_amdgcn_s_barrier(); asm volatile("" ::: "memory");
            if (i + 2 < nB) { const int dn = DESC_B(i + 2); ATT_ISSUE(dn, cnt + 2); }
            const LAS unsigned char* Kb = lds + (cnt % 3) * SLOT_BYTES; const LAS unsigned char* Vb = Kb + 8192;
            const int dsc = DESC_B(i), kind = dsc >> 8, j = dsc & 255;
            if (i == nslc) {
                const float sc = l > 0.f ? gate1 / l : 0.f;
#pragma unroll
                for (int e = 0; e < 16; ++e) { outst[e * 64] += sc * o[0][e]; outst[(16 + e) * 64] += sc * o[1][e]; o[0][e] = 0.f; o[1][e] = 0.f; }
                m = NEGV; l = 0.f;
            }
            if (kind == 2) tile_compute<2, true>(Kb, Vb, qf, o, m, l, 0.f, j, t, slope2, ((selmask >> j) & 1ull) != 0ull, qb, ql, hh, prim, carry);
            else if (kind == 3) tile_compute<2, false>(Kb, Vb, qf, o, m, l, 0.f, j, t, slope2, ((selmask >> j) & 1ull) != 0ull, qb, ql, hh, prim, carry);
            else if (kind == 4) tile_compute<3, true>(Kb, Vb, qf, o, m, l, 0.f, j, t, slope2, true, qb, ql, hh, prim, carry);
            else tile_compute<3, false>(Kb, Vb, qf, o, m, l, 0.f, j, t, slope2, true, qb, ql, hh, prim, carry);
            ++cnt;
        }
        {
            const float sc = l > 0.f ? gate2 / l : 0.f;
#pragma unroll
            for (int e = 0; e < 16; ++e) { o[0][e] = outst[e * 64] + sc * o[0][e]; o[1][e] = outst[(16 + e) * 64] + sc * o[1][e]; }
        }
        GAS bf16_t* op = O + token * 512 + head * 64 + 4 * hh;
#pragma unroll
        for (int dsub = 0; dsub < 2; ++dsub)
#pragma unroll
            for (int i4 = 0; i4 < 4; ++i4) {
                u32x2 w; w.x = cvt_pk_bf16(o[dsub][4 * i4 + 0], o[dsub][4 * i4 + 1]); w.y = cvt_pk_bf16(o[dsub][4 * i4 + 2], o[dsub][4 * i4 + 3]);
                *(GAS u32x2*)(op + dsub * 32 + 8 * i4) = w;
            }
        __syncthreads();
    }
#undef ATT_ISSUE
#undef DESC_A
#undef DESC_B
}
}

#define XB_TMO      128
#define XB_XCNT(j)  (256  + 64 * (j))
#define XB_XSUB(j)  (1280 + 64 * (j))
#define XB_XGEN(j)  (2304 + 64 * (j))
#define XB_TOP      3328
#define XB_TOPGEN   3392
#define XCD_BAR_WORDS 3456
#define XB_SPIN_CAP (1u << 18)

__device__ __forceinline__ unsigned xb_ld(unsigned* p)              { return __hip_atomic_load(p, __ATOMIC_RELAXED, __HIP_MEMORY_SCOPE_AGENT); }
__device__ __forceinline__ unsigned xb_add(unsigned* p, unsigned v) { return __hip_atomic_fetch_add(p, v, __ATOMIC_RELAXED, __HIP_MEMORY_SCOPE_AGENT); }
__device__ __forceinline__ unsigned xb_xcc_id() { return (unsigned)__builtin_amdgcn_s_getreg((3 << 11) | 20) & 0xFu; }
#define XB_SPIN(cond, bar) do { unsigned _sp = 0; while (cond) { __builtin_amdgcn_s_sleep(1); \
    if ((++_sp & 255u) == 0u) { if (xb_ld(&(bar)[XB_TMO])) break; if (_sp > XB_SPIN_CAP) { atomicAdd(&(bar)[XB_TMO], 1u); break; } } } } while (0)

struct XcdBarrier {
    unsigned* bar; unsigned x;
    volatile LAS unsigned* st;
};

__device__ __forceinline__ XcdBarrier xcd_barrier_post(unsigned* bar, volatile LAS unsigned* st) {
    XcdBarrier b; b.bar = bar; b.x = xb_xcc_id(); b.st = st;
    if (threadIdx.x == 0) (void)xb_add(&bar[XB_XCNT(b.x)], 1u);
    return b;
}
__device__ __forceinline__ void xcd_barrier_complete(unsigned* bar, unsigned x, unsigned& nloc, unsigned& nx) {
    const unsigned G = gridDim.x * gridDim.y * gridDim.z;
    unsigned sum, cnt, mine, sp = 0u;
    for (;;) {
        sum = 0u; cnt = 0u; mine = 0u;
#pragma unroll
        for (unsigned j = 0; j < 16; ++j) { const unsigned c = xb_ld(&bar[XB_XCNT(j)]); sum += c; cnt += (c > 0u) ? 1u : 0u; mine = (j == x) ? c : mine; }
        if (sum == G) break;
        __builtin_amdgcn_s_sleep(1);
        if ((++sp & 255u) == 0u) { if (xb_ld(&bar[XB_TMO])) break; if (sp > XB_SPIN_CAP) { atomicAdd(&bar[XB_TMO], 1u); break; } }
    }
    nloc = mine > 0u ? mine : 1u; nx = cnt > 0u ? cnt : 1u;
}

__device__ __forceinline__ void xcd_barrier(const XcdBarrier& b) {
    asm volatile("s_waitcnt vmcnt(0)" ::: "memory");
    __syncthreads();
    if (threadIdx.x == 0) {
        unsigned* bar = b.bar;
        __builtin_amdgcn_s_waitcnt(0);
        unsigned nloc = b.st[0], nx = b.st[1];
        if (nloc == 0u) { xcd_barrier_complete(bar, b.x, nloc, nx); b.st[0] = nloc; b.st[1] = nx; }
        const unsigned old = xb_add(&bar[XB_XSUB(b.x)], 1u);
        const unsigned gen = old / nloc;
        if (old + 1u == (gen + 1u) * nloc) {
            __builtin_amdgcn_fence(__ATOMIC_RELEASE, "agent");
            asm volatile("s_waitcnt vmcnt(0)" ::: "memory");
            const unsigned og = xb_add(&bar[XB_TOP], 1u);
            const unsigned tg = og / nx;
            if (og + 1u == (tg + 1u) * nx) xb_add(&bar[XB_TOPGEN], 1u);
            else XB_SPIN(xb_ld(&bar[XB_TOPGEN]) == tg, bar);
            __builtin_amdgcn_fence(__ATOMIC_ACQUIRE, "agent");
            xb_add(&bar[XB_XGEN(b.x)], 1u);
            asm volatile("s_waitcnt vmcnt(0)" ::: "memory");
        } else {
            XB_SPIN(xb_ld(&bar[XB_XGEN(b.x)]) == gen, bar);
            __builtin_amdgcn_fence(__ATOMIC_ACQUIRE, "agent");
            asm volatile("s_waitcnt vmcnt(0)" ::: "memory");
        }
    }
    __syncthreads();
}

struct Args { const float* in[28]; float* out; unsigned char* ws; };

constexpr int PTAB_OFF = 143360;
__device__ __forceinline__ GAS const float* karg(const LAS unsigned char* lds, int slot) {
    const LAS unsigned* pt = (const LAS unsigned*)(lds + PTAB_OFF) + 2 * slot;
    const unsigned lo = __builtin_amdgcn_readfirstlane(pt[0]), hi = __builtin_amdgcn_readfirstlane(pt[1]);
    return (GAS const float*)(((unsigned long long)hi << 32) | lo);
}
#define INP(i) karg(lds, i)
#define WSB(off) ((GAS bf16_t*)((GAS unsigned char*)karg(lds, 29) + (off)))
#define WSF(off) ((GAS float*)((GAS unsigned char*)karg(lds, 29) + (off)))
#define XOUT ((GAS float*)karg(lds, 28))
constexpr int XBST_OFF = PTAB_OFF + 512;
#define GRID_BAR() do { XcdBarrier b_; b_.bar = (unsigned*)(GAS unsigned*)karg(lds, 29); b_.x = xb_xcc_id(); b_.st = (volatile LAS unsigned*)(lds + XBST_OFF); xcd_barrier(b_); } while (0)

__global__ void __launch_bounds__(512, 2) mega_fwd(Args a) {
    extern __shared__ __attribute__((aligned(16))) unsigned char lds_raw[];
    LAS unsigned char* lds = (LAS unsigned char*)lds_raw;
    cg::grid_group grid = cg::this_grid();
    const int tid = threadIdx.x, lane = tid & 63, wave = __builtin_amdgcn_readfirstlane(tid >> 6);
    const int G = gridDim.x, bid = blockIdx.x;
    const int gw = bid * 8 + wave, NGW = G * 8;
    if (tid == 0) {
        LAS unsigned long long* pt = (LAS unsigned long long*)(lds + PTAB_OFF);
#pragma unroll
        for (int i = 0; i < 28; ++i) pt[i] = (unsigned long long)a.in[i];
        pt[28] = (unsigned long long)a.out; pt[29] = (unsigned long long)a.ws;
        volatile LAS unsigned* st = (volatile LAS unsigned*)(lds + XBST_OFF); st[0] = 0u; st[1] = 0u;
    }
    __syncthreads();
    (void)xcd_barrier_post((unsigned*)a.ws, (volatile LAS unsigned*)(lds + XBST_OFF));

    {
        LAS float* cact = (LAS float*)lds;
        GAS const float* c = INP(1);
        for (int i = tid; i < NBATCH * D; i += 512) { const int bb = i >> 10, k = i & 1023; cact[k * 16 + bb] = siluf_(c[i]); }
        __syncthreads();
        for (int item = bid; item < NADA / 64; item += G) {
            const int j = item * 64 + lane; GAS const float* w = INP(4) + j + (size_t)(wave * 128) * NADA;
            float acc[16];
#pragma unroll
            for (int bb = 0; bb < 16; ++bb) acc[bb] = 0.f;
#pragma unroll 16
            for (int k = 0; k < 128; ++k) {
                const float wv = w[(size_t)k * NADA];
                const LAS f32x4* cp = (const LAS f32x4*)(cact + (wave * 128 + k) * 16);
                const f32x4 c0 = cp[0], c1 = cp[1], c2 = cp[2], c3 = cp[3];
                acc[0] += c0.x * wv; acc[1] += c0.y * wv; acc[2] += c0.z * wv; acc[3] += c0.w * wv;
                acc[4] += c1.x * wv; acc[5] += c1.y * wv; acc[6] += c1.z * wv; acc[7] += c1.w * wv;
                acc[8] += c2.x * wv; acc[9] += c2.y * wv; acc[10] += c2.z * wv; acc[11] += c2.w * wv;
                acc[12] += c3.x * wv; acc[13] += c3.y * wv; acc[14] += c3.z * wv; acc[15] += c3.w * wv;
            }
            LAS float* part = (LAS float*)(lds + 65536);
#pragma unroll
            for (int bb = 0; bb < 16; ++bb) part[wave * 1024 + bb * 64 + lane] = acc[bb];
            __syncthreads();
#pragma unroll
            for (int h = 0; h < 2; ++h) {
                const int bsel = (tid >> 6) + 8 * h, col = tid & 63;
                float sum = 0.f;
#pragma unroll
                for (int w8 = 0; w8 < 8; ++w8) sum += part[w8 * 1024 + bsel * 64 + col];
                WSF(WS_ADA)[(size_t)bsel * NADA + item * 64 + col] = sum + INP(5)[item * 64 + col];
            }
            __syncthreads();
        }
        LAS float* scr = (LAS float*)(lds + 65536 + wave * 8448);
        constexpr int I_WA = 1024;
        constexpr int I_IN = 16 * (2 * DFF / 32), I_OUT = (DFF / 64) * 32, I_MIX = 16 * (NZ / 32), I_WB = 8 * 32, I_MO = 16 * 32, I_C1 = 32 * 8, I_C2 = 4 * 8;
        constexpr int NITEMS = I_WA + 2 * I_IN + 2 * I_OUT + I_MIX + I_WB + I_MO + 2 * I_C1 + 2 * I_C2;
        for (int it = gw; it < NITEMS; it += NGW) {
            int r = it;
            if (r < I_WA) {
                const int gq = r >> 8, rem = r & 255, c0 = (rem >> 4) * 8, n0 = (rem & 15) * 64;
                GAS const float* pw = INP(11) + ((size_t)gq * 128 + c0) * 128; GAS const float* psc = INP(12) + gq * 128; GAS const float* wba = INP(19) + (size_t)gq * 128 * D + n0 + lane;
                float acc[8];
#pragma unroll
                for (int ci = 0; ci < 8; ++ci) acc[ci] = 0.f;
#pragma unroll 16
                for (int d = 0; d < 128; ++d) {
                    const float wv = wba[(size_t)d * D] * psc[d];
#pragma unroll
                    for (int ci = 0; ci < 8; ++ci) acc[ci] += pw[ci * 128 + d] * wv;
                }
                u32x4 o; o.x = cvt_pk_bf16(acc[0], acc[1]); o.y = cvt_pk_bf16(acc[2], acc[3]); o.z = cvt_pk_bf16(acc[4], acc[5]); o.w = cvt_pk_bf16(acc[6], acc[7]);
                *(GAS u32x4*)(WSB(WS_WA) + (size_t)(n0 + lane) * 512 + gq * 128 + c0) = o;
                continue;
            }
            r -= I_WA;
            if (r < I_IN) { tr_item(INP(6), 2 * DFF, WSB(WS_W1IN), D, 1, scr, r, 2 * DFF / 32, lane); continue; } r -= I_IN;
            if (r < I_IN) { tr_item(INP(24), 2 * DFF, WSB(WS_W2IN), D, 1, scr, r, 2 * DFF / 32, lane); continue; } r -= I_IN;
            if (r < I_OUT) { tr_item(INP(7), D, WSB(WS_W1OUT), DFF, 0, scr, r, 32, lane); continue; } r -= I_OUT;
            if (r < I_OUT) { tr_item(INP(25), D, WSB(WS_W2OUT), DFF, 0, scr, r, 32, lane); continue; } r -= I_OUT;
            if (r < I_MIX) { tr_item(INP(10), 3864, WSB(WS_WMIX), D, 2, scr, r, NZ / 32, lane); continue; } r -= I_MIX;
            if (r < I_WB) { tr_item(INP(20), D, WSB(WS_WB), 512, 0, scr, r, 32, lane); continue; } r -= I_WB;
            if (r < I_MO) { tr_item(INP(21), D, WSB(WS_WMO), D, 0, scr, r, 32, lane); continue; } r -= I_MO;
            if (r < I_C1) { tr_item(INP(14), 256, WSB(WS_CKW1), 2048, 0, scr, r, 8, lane); continue; } r -= I_C1;
            if (r < I_C1) { tr_item(INP(17), 256, WSB(WS_CVW1), 2048, 0, scr, r, 8, lane); continue; } r -= I_C1;
            if (r < I_C2) { tr_item(INP(15), 64, WSB(WS_CKW2), 256, 3, scr, r, 8, lane); continue; } r -= I_C2;
            tr_item(INP(18), 64, WSB(WS_CVW2), 256, 3, scr, r, 8, lane);
        }
    }
    GRID_BAR();
    if (gridDim.x == 0u) grid.sync();
    ln_rows<false, true, false, false, false, false>(INP(0), WSB(WS_H), XOUT, WSB(WS_H), INP(2), INP(3), WSF(WS_ADA), 0, INP(2), INP(3), gw, NGW, lane);
    GRID_BAR();
    pg8::StaticOrder S;
#ifndef REP_G1
#define REP_G1 1
#endif
#pragma unroll 1
    for (int rep = 0; rep < REP_G1; ++rep)
    { pg8::Gemm g{WSB(WS_H), WSB(WS_W1IN), M, 2 * DFF, D, D, D}; S.init(M, 2 * DFF, G, bid); pg8::EpiSwiglu E{WSB(WS_ACT)}; pg8::gemm_phase(lds, g, S, E); }
    GRID_BAR();
    { pg8::Gemm g{WSB(WS_ACT), WSB(WS_W1OUT), M, D, DFF, DFF, DFF}; S.init(M, D, G, bid); pg8::EpiY E{WSB(WS_H), WSF(WS_ADA) + 2 * D, 0.5f}; pg8::gemm_phase(lds, g, S, E); }
    GRID_BAR();
    ln_rows<true, true, true, true, false, true>(INP(0), WSB(WS_H), XOUT, WSB(WS_H), INP(8), INP(9), WSF(WS_ADA), 1, INP(2), INP(3), gw, NGW, lane);
    GRID_BAR();
#if MIXER_MODE >= 1
    { pg8::Gemm g{WSB(WS_H), WSB(WS_WMIX), M, NZ, D, D, D}; S.init(M, NZ, G, bid); pg8::EpiZ E{WSB(WS_ACT)}; pg8::gemm_phase(lds, g, S, E); }
    GRID_BAR();
    {
        constexpr int I_DELTA = M / 32, I_VT = 2 * 32 * 64, I_BLK = 2 * 8192 / 4;
        LAS unsigned char* tsc = lds + wave * 9216;
        GAS const bf16_t* Zp = WSB(WS_ACT);
#define UNPK8(v_, f_) do { f_[0] = bf_lo(v_.x); f_[1] = bf_hi(v_.x); f_[2] = bf_lo(v_.y); f_[3] = bf_hi(v_.y); f_[4] = bf_lo(v_.z); f_[5] = bf_hi(v_.z); f_[6] = bf_lo(v_.w); f_[7] = bf_hi(v_.w); } while (0)
        for (int it = gw; it < I_DELTA + I_VT + I_BLK; it += NGW) {
            int r = it;
            if (r < I_DELTA) {
                const int tok0 = r * 32, tpos0 = tok0 & (SEQ - 1), w = 2 << (lane >> 4);
                GAS const bf16_t* zp = Zp + (size_t)tok0 * NZ + lane * 8;
                GAS bf16_t* dp = WSB(WS_DELTA) + (size_t)tok0 * 512 + lane * 8;
                float sum[8];
#pragma unroll
                for (int e = 0; e < 8; ++e) sum[e] = 0.f;
#pragma unroll
                for (int i = 1; i < 16; ++i) {
                    if (i < w && tpos0 - i >= 0) {
                        const u32x4 v = *(GAS const u32x4*)(zp - (long)i * NZ); float f[8]; UNPK8(v, f);
#pragma unroll
                        for (int e = 0; e < 8; ++e) sum[e] += f[e];
                    }
                }
#pragma unroll 1
                for (int s4 = 0; s4 < 32; s4 += 4) {
                    u32x4 cur[4], old[4];
#pragma unroll
                    for (int q = 0; q < 4; ++q) {
                        cur[q] = *(GAS const u32x4*)(zp + (long)(s4 + q) * NZ);
                        const int back = s4 + q - w + 1;
                        old[q] = (tpos0 + back >= 0) ? *(GAS const u32x4*)(zp + (long)back * NZ) : (u32x4){0u, 0u, 0u, 0u};
                    }
#pragma unroll
                    for (int q = 0; q < 4; ++q) {
                        float f[8], fo[8]; UNPK8(cur[q], f); UNPK8(old[q], fo);
                        const int tpos = tpos0 + s4 + q; const int cnt = (tpos + 1) < w ? (tpos + 1) : w;
                        const float ic = 1.0f / (float)cnt;
#pragma unroll
                        for (int e = 0; e < 8; ++e) sum[e] += f[e];
                        u32x4 o; o.x = cvt_pk_bf16(sum[0] * ic - f[0], sum[1] * ic - f[1]); o.y = cvt_pk_bf16(sum[2] * ic - f[2], sum[3] * ic - f[3]);
                        o.z = cvt_pk_bf16(sum[4] * ic - f[4], sum[5] * ic - f[5]); o.w = cvt_pk_bf16(sum[6] * ic - f[6], sum[7] * ic - f[7]);
                        *(GAS u32x4*)(dp + (size_t)(s4 + q) * 512) = o;
#pragma unroll
                        for (int e = 0; e < 8; ++e) sum[e] -= fo[e];
                    }
                }
                continue;
            }
            r -= I_DELTA;
            if (r < I_VT) {
                const int which = r >> 11, rem = r & 2047, bg = rem >> 6, tile = rem & 63, b = bg >> 1, g = bg & 1;
                GAS const bf16_t* src = Zp + ((size_t)b * SEQ + tile * 64) * NZ + (which ? ZC_VWIN : ZC_VSLC) + g * 64;
                GAS bf16_t* dst = (which ? WSB(WS_VTW) : WSB(WS_VTS)) + (size_t)bg * 64 * SEQ + tile * 64;
                u32x4 vv[8];
#pragma unroll
                for (int i = 0; i < 8; ++i) vv[i] = *(GAS const u32x4*)(src + (size_t)(i * 8 + (lane >> 3)) * NZ + (lane & 7) * 8);
#pragma unroll
                for (int i = 0; i < 8; ++i) {
                    const int row = i * 8 + (lane >> 3), ch = lane & 7; const u32x4 v = vv[i];
                    LAS bf16_t* tp = (LAS bf16_t*)tsc + (ch * 8) * 72 + row;
                    tp[0 * 72] = (bf16_t)(v.x & 0xffffu); tp[1 * 72] = (bf16_t)(v.x >> 16); tp[2 * 72] = (bf16_t)(v.y & 0xffffu); tp[3 * 72] = (bf16_t)(v.y >> 16);
                    tp[4 * 72] = (bf16_t)(v.z & 0xffffu); tp[5 * 72] = (bf16_t)(v.z >> 16); tp[6 * 72] = (bf16_t)(v.w & 0xffffu); tp[7 * 72] = (bf16_t)(v.w >> 16);
                }
                LDS_WAIT(); asm volatile("" ::: "memory");
#pragma unroll
                for (int i = 0; i < 8; ++i) {
                    const int d = i * 8 + (lane >> 3), ch = lane & 7;
                    const u32x4 v = *(const LAS u32x4*)(tsc + d * 144 + ch * 16);
                    *(GAS u32x4*)(dst + (size_t)d * SEQ + ch * 8) = v;
                }
                LDS_WAIT(); asm volatile("" ::: "memory");
                continue;
            }
            r -= I_VT;
            {
                const int which = r >> 11, rowbase = (r & 2047) * 4, bg = rowbase >> 8, b = bg >> 1, g = bg & 1;
                GAS const float* pos = which ? INP(16) : INP(13);
                GAS bf16_t* dst = (which ? WSB(WS_VBLK) : WSB(WS_KBLK)) + (size_t)rowbase * 2048;
                GAS const bf16_t* src = Zp + (size_t)b * SEQ * NZ + (which ? ZC_VCMP : ZC_KCMP) + g * 64;
                u32x4 vv[4][4];
#pragma unroll
                for (int rr = 0; rr < 4; ++rr) {
                    const int n = (rowbase + rr) & 255;
#pragma unroll
                    for (int i = 0; i < 4; ++i) {
                        const int ch = lane + 64 * i, pp = ch >> 3, dc = ch & 7;
                        vv[rr][i] = (n < 255) ? *(GAS const u32x4*)(src + (size_t)(16 * n + pp) * NZ + dc * 8) : (u32x4){0u, 0u, 0u, 0u};
                    }
                }
#pragma unroll
                for (int i = 0; i < 4; ++i) {
                    const int ch = lane + 64 * i, pp = ch >> 3, dc = ch & 7;
                    const f32x4 p0 = *(GAS const f32x4*)(pos + pp * 64 + dc * 8), p1 = *(GAS const f32x4*)(pos + pp * 64 + dc * 8 + 4);
#pragma unroll
                    for (int rr = 0; rr < 4; ++rr) {
                        const int n = (rowbase + rr) & 255; const u32x4 v = vv[rr][i];
                        u32x4 o = (u32x4){0u, 0u, 0u, 0u};
                        if (n < 255) {
                            o.x = cvt_pk_bf16(bf_lo(v.x) + p0.x, bf_hi(v.x) + p0.y); o.y = cvt_pk_bf16(bf_lo(v.y) + p0.z, bf_hi(v.y) + p0.w);
                            o.z = cvt_pk_bf16(bf_lo(v.z) + p1.x, bf_hi(v.z) + p1.y); o.w = cvt_pk_bf16(bf_lo(v.w) + p1.z, bf_hi(v.w) + p1.w);
                        }
                        *(GAS u32x4*)(dst + (size_t)rr * 2048 + ch * 8) = o;
                    }
                }
            }
        }
#undef UNPK8
    }
    GRID_BAR();
#if MIXER_MODE >= 2
#pragma unroll 1
    for (int s = 0; s < 2; ++s) {
        pg8::Gemm g{s ? WSB(WS_VBLK) : WSB(WS_KBLK), s ? WSB(WS_CVW1) : WSB(WS_CKW1), 8192, 256, 2048, 2048, 2048}; S.init(8192, 256, G, s ? (bid + G - 32) % G : bid);
        pg8::EpiCmp1 E{s ? WSB(WS_HIDV) : WSB(WS_HIDK)}; pg8::gemm_phase(lds, g, S, E);
    }
    __syncthreads();
#pragma unroll 1
    for (int s = 0; s < 2; ++s) {
        pg8::Gemm g{s ? WSB(WS_HIDV) : WSB(WS_HIDK), s ? WSB(WS_CVW2) : WSB(WS_CKW2), 8192, 256, 256, 256, 256}; S.init(8192, 256, G, s ? (bid + G - 32) % G : bid);
        pg8::EpiCmp2 E{s ? WSB(WS_VCT) : WSB(WS_KC), s}; pg8::gemm_phase(lds, g, S, E);
    }
    if (bid >= 64 && G > 64) {
        pg8::Gemm g{WSB(WS_DELTA), WSB(WS_WA), M, D, 512, 512, 512}; S.init(M, D, G - 64, bid - 64); pg8::EpiGate E{WSB(WS_ACT), WSB(WS_H), ZC_GA, 0}; pg8::gemm_phase(lds, g, S, E);
    }
    GRID_BAR();
#ifndef REP_ATT
#define REP_ATT 1
#endif
#pragma unroll 1
    for (int rep = 0; rep < REP_ATT; ++rep)
        att::attn_phase(lds, WSB(WS_ACT), WSB(WS_VTS), WSB(WS_VTW), WSB(WS_KC), WSB(WS_VCT), WSB(WS_O), G, bid);
    GRID_BAR();
#endif
    if (G <= 64) { pg8::Gemm g{WSB(WS_DELTA), WSB(WS_WA), M, D, 512, 512, 512}; S.init(M, D, G, bid); pg8::EpiGate E{WSB(WS_ACT), WSB(WS_H), ZC_GA, 0}; pg8::gemm_phase(lds, g, S, E); }
#if MIXER_MODE >= 2
    { pg8::Gemm g{WSB(WS_O), WSB(WS_WB), M, D, 512, 512, 512}; S.init(M, D, G, bid); pg8::EpiGate E{WSB(WS_ACT), WSB(WS_H), ZC_GB, 1}; pg8::gemm_phase(lds, g, S, E); }
#endif
    GRID_BAR();
    { pg8::Gemm g{WSB(WS_H), WSB(WS_WMO), M, D, D, D, D}; S.init(M, D, G, bid); pg8::EpiY E{WSB(WS_DELTA), WSF(WS_ADA) + 5 * D, 1.0f}; pg8::gemm_phase(lds, g, S, E); }
    GRID_BAR();
#else
    for (size_t i = (size_t)bid * 512 + tid; i < (size_t)M * D / 4; i += (size_t)G * 512) { f32x4 v = ((GAS f32x4*)XOUT)[i]; ((GAS f32x4*)XOUT)[i] = v * ALPHA; }
    GRID_BAR();
#endif
    ln_rows<true, true, true, false, true, true>(XOUT, WSB(WS_DELTA), WSB(WS_DELTA), WSB(WS_H), INP(22), INP(23), WSF(WS_ADA), 2, INP(2), INP(3), gw, NGW, lane);
    GRID_BAR();
    { pg8::Gemm g{WSB(WS_H), WSB(WS_W2IN), M, 2 * DFF, D, D, D}; S.init(M, 2 * DFF, G, bid); pg8::EpiSwiglu E{WSB(WS_ACT)}; pg8::gemm_phase(lds, g, S, E); }
    GRID_BAR();
    { pg8::Gemm g{WSB(WS_ACT), WSB(WS_W2OUT), M, D, DFF, DFF, DFF}; S.init(M, D, G, bid); pg8::EpiY E{WSB(WS_H), WSF(WS_ADA) + 8 * D, 0.5f}; pg8::gemm_phase(lds, g, S, E); }
    GRID_BAR();
    ln_rows<true, false, true, false, true, false>(WSB(WS_DELTA), WSB(WS_H), XOUT, WSB(WS_H), INP(26), INP(27), WSF(WS_ADA), 0, INP(2), INP(3), gw, NGW, lane);
}

extern "C" void kernel_launch(void* const* d_in, const int* in_sizes, int n_in, void* d_out, int out_size, void* d_ws, size_t ws_size, hipStream_t stream) {
    static int grid = 0;
    if (grid == 0) {
        if (n_in != 28 || out_size != M * D || ws_size < WS_END) { fprintf(stderr, "kernel_launch: unexpected shapes (n_in %d out %d ws %zu)\n", n_in, out_size, ws_size); grid = -1; return; }
        int dev = 0, cus = 0, per_cu = 0;
        hipGetDevice(&dev);
        hipDeviceGetAttribute(&cus, hipDeviceAttributeMultiprocessorCount, dev);
        if (hipFuncSetAttribute((const void*)mega_fwd, hipFuncAttributeMaxDynamicSharedMemorySize, LDS_BYTES) != hipSuccess) { fprintf(stderr, "kernel_launch: hipFuncSetAttribute failed\n"); grid = -1; return; }
        if (hipOccupancyMaxActiveBlocksPerMultiprocessor(&per_cu, (const void*)mega_fwd, 512, LDS_BYTES) != hipSuccess || per_cu < 1) { fprintf(stderr, "kernel_launch: occupancy query says %d\n", per_cu); per_cu = 1; }
        (void)hipGetLastError();
        grid = cus * per_cu;
    }
    if (grid < 0) return;
    if (hipMemsetAsync(d_ws, 0, 16384, stream) != hipSuccess) { fprintf(stderr, "kernel_launch: hipMemsetAsync of the barrier words failed\n"); return; }
    Args a{};
    for (int i = 0; i < 28; ++i) a.in[i] = (const float*)d_in[i];
    a.out = (float*)d_out; a.ws = (unsigned char*)d_ws;
    void* args[] = {&a};
    hipError_t e = hipLaunchCooperativeKernel((const void*)mega_fwd, dim3(grid), dim3(512), args, LDS_BYTES, stream);
    if (e != hipSuccess) fprintf(stderr, "cooperative launch failed: %s (grid %d)\n", hipGetErrorString(e), grid);
}
```
